# Optimizing an MI355X kernel written in HIP

```python
import math
import jax, jax.numpy as jnp
from jax import lax
import numpy as np

D_MODEL = 2048
BATCH = 8
SEQ = 2048
DEPTH = 1

PLE_DIM = 256
D_FF = 5632
DIFF_HEADS = 8
DIFF_HEAD_DIM = 64
DIFF_V_DIM = 2 * DIFF_HEAD_DIM
DIFF_WIDTH = DIFF_HEADS * 2 * DIFF_HEAD_DIM
HGRN_HEADS = 8
HGRN_K = 128
HGRN_V = 128
HGRN_WIDTH = HGRN_HEADS * HGRN_K
HGRN_CHUNK = 64
Q_BLOCK = 128
REL_BUCKETS = 32
REL_MAX_DIST = 128
N_IN = 3 * DIFF_WIDTH + 4 * HGRN_WIDTH + 2 * D_MODEL
EPS = 1e-6

kernel_name = "hybrid_diffattn_hgrn2_macaron_block"


def rmsnorm(x, g):
    xf = x.astype(jnp.float32)
    y = xf * lax.rsqrt(jnp.mean(xf * xf, axis=-1, keepdims=True) + EPS)
    return (y * g.astype(jnp.float32)).astype(x.dtype)


def swiglu(h, w_gate, w_up, w_down):
    return (jax.nn.silu(h @ w_gate) * (h @ w_up)) @ w_down


def t5_bucket(dist):
    n = jnp.maximum(dist, 0)
    max_exact = REL_BUCKETS // 2
    nf = jnp.maximum(n, 1).astype(jnp.float32)
    large = max_exact + (jnp.log(nf / max_exact) / math.log(REL_MAX_DIST / max_exact)
                         * (REL_BUCKETS - max_exact)).astype(jnp.int32)
    large = jnp.minimum(large, REL_BUCKETS - 1)
    return jnp.where(n < max_exact, n, large)


def diff_attention(q, k, v, q_gain, k_gain, lam, rel_bias, subln_gain, lambda_init):
    B, S, _ = q.shape
    q = rmsnorm(q.reshape(B, S, DIFF_HEADS, 2, DIFF_HEAD_DIM), q_gain).transpose(0, 2, 3, 1, 4)
    k = rmsnorm(k.reshape(B, S, DIFF_HEADS, 2, DIFF_HEAD_DIM), k_gain).transpose(0, 2, 3, 1, 4)
    v = v.reshape(B, S, DIFF_HEADS, DIFF_V_DIM).transpose(0, 2, 1, 3).astype(jnp.float32)
    q1, q2 = q[:, :, 0], q[:, :, 1]
    k1, k2 = k[:, :, 0], k[:, :, 1]
    scale = DIFF_HEAD_DIM ** -0.5
    k_pos = jnp.arange(S)

    def block(blk):
        start = blk * Q_BLOCK
        q1b = lax.dynamic_slice_in_dim(q1, start, Q_BLOCK, axis=2)
        q2b = lax.dynamic_slice_in_dim(q2, start, Q_BLOCK, axis=2)
        dist = (start + jnp.arange(Q_BLOCK))[:, None] - k_pos[None, :]
        bias = jnp.transpose(rel_bias[t5_bucket(dist)], (2, 0, 1)).astype(jnp.float32)
        visible = dist >= 0

        def probs(qb, kk):
            s = jnp.einsum('bhqd,bhkd->bhqk', qb, kk).astype(jnp.float32) * scale + bias
            return jax.nn.softmax(jnp.where(visible, s, -jnp.inf), axis=-1)

        a = probs(q1b, k1) - lam * probs(q2b, k2)
        return jnp.einsum('bhqk,bhkv->bhqv', a, v)

    o = lax.map(block, jnp.arange(S // Q_BLOCK))
    o = o.transpose(1, 0, 3, 2, 4).reshape(B, S, DIFF_HEADS, DIFF_V_DIM)
    o = rmsnorm(o, subln_gain) * (1.0 - lambda_init)
    return o.reshape(B, S, DIFF_WIDTH).astype(q.dtype)


def hgrn2(q, f_pre, i_in, og, lb, norm_gain):
    B, S, _ = q.shape
    nc = S // HGRN_CHUNK
    f32 = jnp.float32

    def chunks(t, dh):
        return t.reshape(B, nc, HGRN_CHUNK, HGRN_HEADS, dh).transpose(1, 0, 3, 2, 4)

    lb = lb.astype(f32)
    forget = lb + (1.0 - lb) * jax.nn.sigmoid(f_pre.astype(f32))
    qf = jax.nn.silu(q.astype(f32))
    kf = 1.0 - forget
    logf = jnp.log(forget)
    tri = jnp.arange(HGRN_CHUNK)[:, None] >= jnp.arange(HGRN_CHUNK)[None, :]

    def step(state, inp):
        qc, kc, vc, gc = inp
        b = jnp.cumsum(gc, axis=2)
        rel = jnp.where(tri[:, :, None], b[:, :, :, None, :] - b[:, :, None, :, :], -jnp.inf)
        scores = jnp.einsum('bhtk,bhsk,bhtsk->bhts', qc, kc, jnp.exp(rel))
        o = (jnp.einsum('bhts,bhsv->bhtv', scores, vc)
             + jnp.einsum('bhtk,bhkv->bhtv', qc * jnp.exp(b), state))
        b_last = b[:, :, -1:, :]
        state = (jnp.exp(b_last[:, :, 0, :])[..., None] * state
                 + jnp.einsum('bhsk,bhsv->bhkv', kc * jnp.exp(b_last - b), vc))
        return state, o

    state0 = jnp.zeros((B, HGRN_HEADS, HGRN_K, HGRN_V), f32)
    _, o = lax.scan(step, state0, (chunks(qf, HGRN_K), chunks(kf, HGRN_K),
                                   chunks(i_in.astype(f32), HGRN_V), chunks(logf, HGRN_K)))
    o = o.transpose(1, 0, 3, 2, 4).reshape(B, S, HGRN_HEADS, HGRN_V)
    o = rmsnorm(o, norm_gain) * jax.nn.silu(og.astype(f32)).reshape(B, S, HGRN_HEADS, HGRN_V)
    return o.reshape(B, S, HGRN_WIDTH).astype(q.dtype)


def setup_inputs(seed: int = 0) -> dict:
    key = jax.random.key(seed)
    ks = jax.random.split(key, 32)

    def nrm(k, shape, scale):
        return jax.random.normal(k, shape, jnp.float32) * scale

    def gain(k, shape):
        return 1.0 + 0.1 * jax.random.normal(k, shape, jnp.float32)

    L = DEPTH
    return {
        'x': nrm(ks[0], (BATCH, SEQ, D_MODEL), 1.0),
        'p': nrm(ks[1], (L, BATCH, SEQ, PLE_DIM), 1.0),
        'ffn1_norm': gain(ks[2], (L, D_MODEL)),
        'ffn1_w_gate': nrm(ks[3], (L, D_MODEL, D_FF), D_MODEL ** -0.5),
        'ffn1_w_up': nrm(ks[4], (L, D_MODEL, D_FF), D_MODEL ** -0.5),
        'ffn1_w_down': nrm(ks[5], (L, D_FF, D_MODEL), D_FF ** -0.5),
        'mix_norm': gain(ks[6], (L, D_MODEL)),
        'w_in': nrm(ks[7], (L, D_MODEL, N_IN), D_MODEL ** -0.5),
        'q_norm': gain(ks[8], (L, DIFF_HEAD_DIM)),
        'k_norm': gain(ks[9], (L, DIFF_HEAD_DIM)),
        'lambda_q1': nrm(ks[10], (L, DIFF_HEAD_DIM), 0.1),
        'lambda_k1': nrm(ks[11], (L, DIFF_HEAD_DIM), 0.1),
        'lambda_q2': nrm(ks[12], (L, DIFF_HEAD_DIM), 0.1),
        'lambda_k2': nrm(ks[13], (L, DIFF_HEAD_DIM), 0.1),
        'diff_subln': gain(ks[14], (L, DIFF_V_DIM)),
        'rel_bias': nrm(ks[15], (REL_BUCKETS, DIFF_HEADS), 0.5),
        'hgrn_lb_logits': nrm(ks[16], (L + 1, HGRN_WIDTH), 0.5),
        'hgrn_norm': gain(ks[17], (L, HGRN_V)),
        'w_branch_a': nrm(ks[18], (L, DIFF_WIDTH, D_MODEL), DIFF_WIDTH ** -0.5),
        'w_branch_b': nrm(ks[19], (L, HGRN_WIDTH, D_MODEL), HGRN_WIDTH ** -0.5),
        'w_out': nrm(ks[20], (L, D_MODEL, D_MODEL), D_MODEL ** -0.5),
        'ffn2_norm': gain(ks[21], (L, D_MODEL)),
        'ffn2_w_gate': nrm(ks[22], (L, D_MODEL, D_FF), D_MODEL ** -0.5),
        'ffn2_w_up': nrm(ks[23], (L, D_MODEL, D_FF), D_MODEL ** -0.5),
        'ffn2_w_down': nrm(ks[24], (L, D_FF, D_MODEL), D_FF ** -0.5),
        'ple_gate_norm': gain(ks[25], (L, D_MODEL)),
        'w_ple_gate': nrm(ks[26], (L, D_MODEL, D_MODEL), D_MODEL ** -0.5),
        'w_ple_proj': nrm(ks[27], (L, PLE_DIM, D_MODEL), PLE_DIM ** -0.5),
        'ple_post_norm': gain(ks[28], (L, D_MODEL)),
    }


def reference(x, p, ffn1_norm, ffn1_w_gate, ffn1_w_up, ffn1_w_down, mix_norm, w_in,
              q_norm, k_norm, lambda_q1, lambda_k1, lambda_q2, lambda_k2, diff_subln,
              rel_bias, hgrn_lb_logits, hgrn_norm, w_branch_a, w_branch_b, w_out,
              ffn2_norm, ffn2_w_gate, ffn2_w_up, ffn2_w_down,
              ple_gate_norm, w_ple_gate, w_ple_proj, ple_post_norm):
    lower_bounds = jnp.cumsum(jax.nn.softmax(hgrn_lb_logits.astype(jnp.float32), axis=0), axis=0)
    split_points = list(np.cumsum([DIFF_WIDTH, DIFF_WIDTH, DIFF_WIDTH,
                                   HGRN_WIDTH, HGRN_WIDTH, HGRN_WIDTH, HGRN_WIDTH, D_MODEL]))
    for i in range(DEPTH):
        x = x + 0.5 * swiglu(rmsnorm(x, ffn1_norm[i]), ffn1_w_gate[i], ffn1_w_up[i], ffn1_w_down[i])

        h = rmsnorm(x, mix_norm[i])
        proj = h @ w_in[i]
        dq, dk, dv, hq, hf, hi, hg, gate_a, gate_b = jnp.split(proj, split_points, axis=-1)

        lambda_init = 0.8 - 0.6 * math.exp(-0.3 * i)
        lam = (jnp.exp(jnp.sum(lambda_q1[i].astype(jnp.float32) * lambda_k1[i].astype(jnp.float32)))
               - jnp.exp(jnp.sum(lambda_q2[i].astype(jnp.float32) * lambda_k2[i].astype(jnp.float32)))
               + lambda_init)
        y_a = diff_attention(dq, dk, dv, q_norm[i], k_norm[i], lam, rel_bias, diff_subln[i], lambda_init)
        y_b = hgrn2(hq, hf, hi, hg, lower_bounds[i], hgrn_norm[i])

        merged = jax.nn.sigmoid(gate_a) * (y_a @ w_branch_a[i]) + jax.nn.sigmoid(gate_b) * (y_b @ w_branch_b[i])
        x = x + merged @ w_out[i]

        x = x + 0.5 * swiglu(rmsnorm(x, ffn2_norm[i]), ffn2_w_gate[i], ffn2_w_up[i], ffn2_w_down[i])

        ple = rmsnorm(p[i] @ w_ple_proj[i], ple_post_norm[i])
        x = x + jax.nn.sigmoid(rmsnorm(x, ple_gate_norm[i]) @ w_ple_gate[i]) * ple
    return x
```

```cpp
#include <hip/hip_runtime.h>
#include <hip/hip_cooperative_groups.h>
#include <cstdio>
#include <cstdint>
namespace cg = cooperative_groups;
namespace pg8 {
#define PG8_LAS __attribute__((address_space(3)))
typedef unsigned short bf16_t;
typedef short bf16x8 __attribute__((ext_vector_type(8)));
typedef float f32x4 __attribute__((ext_vector_type(4)));
typedef unsigned u32x4 __attribute__((ext_vector_type(4)));
constexpr int BM = 256, BK = 64, HALF = 128, HTB = HALF * BK * 2  , STAGE_BYTES = 8 * HTB, NXCD = 8, WGM = 8;

__host__ __device__ __forceinline__ int lds_byte(int r, int c) { const int st = (r >> 4) * 2 + (c >> 5), rr = r & 15, cc = c & 31, ob = rr * 64 + cc * 2; return st * 1024 + (ob ^ (((ob >> 9) & 1) << 5)); }
__host__ __device__ __forceinline__ void stage_rc(int b, int& R, int& C) { const int st = b / 1024, sb = b % 1024, swz = sb ^ (((sb >> 9) & 1) << 5); R = (st >> 1) * 16 + swz / 64; C = (st & 1) * 32 + (swz % 64) / 2; }
__host__ __device__ __forceinline__ int perm32(int rho) { const int n = rho >> 4, i = rho & 15; return 8 * (i >> 2) + 4 * n + (i & 3); }

struct Unit { int pm, pn; };
struct Gemm { const bf16_t* A; const bf16_t* Bt; int M, N, K; };

struct StaticOrder {
    int nM, nN, nwg, G, c;
    __host__ __device__ void init(int M, int N, int G_, int c_) { nM = M / BM; nN = N / BM; nwg = nM * nN; G = G_; c = c_; }
    __host__ __device__ bool next(int i, Unit& u) const {
        const long L = (long)i * G + c; if (L >= nwg) return false;
        int wgid = (int)L; { const int q = nwg / NXCD, r = nwg % NXCD, xcd = wgid % NXCD, off = wgid / NXCD; wgid = (xcd < r ? xcd * (q + 1) : r * (q + 1) + (xcd - r) * q) + off; }
        const int nig = WGM * nN, gid = wgid / nig, fm = gid * WGM, gsz = (nM - fm) < WGM ? (nM - fm) : WGM;
        u.pm = fm + ((wgid % nig) % gsz); u.pn = (wgid % nig) / gsz; return true;
    }
    __device__ __forceinline__ void a_ready(const Unit&) const {}
    __device__ __forceinline__ void done(const Unit&) const {}
};

__device__ __forceinline__ unsigned cvt_pk_bf16(float lo, float hi) { unsigned r; asm volatile("v_cvt_pk_bf16_f32 %0, %1, %2" : "=v"(r) : "v"(lo), "v"(hi)); return r; }
typedef float f32x2 __attribute__((ext_vector_type(2)));
template <class Epi, class Sched, bool ALIGN_EPI = false, bool SP2 = false>
__device__ __forceinline__ void gemm_phase(PG8_LAS unsigned char* lds, const Gemm g, const Sched& S, const Epi& E) {
    const int tid = threadIdx.x, wid = __builtin_amdgcn_readfirstlane(tid >> 6), lane = tid & 63, wr = wid >> 2, wc = wid & 3, fr = lane & 15, fq = lane >> 4;
    const int K = g.K, nt = K / BK;
    unsigned voffA[2], voffB[2];
#pragma unroll
    for (int i = 0; i < 2; ++i) { int R, C; stage_rc(tid * 16 + i * 8192, R, C); const int Rb = Epi::PERM ? ((R & ~31) + perm32(R & 31)) : R;
        voffA[i] = (unsigned)(R * K + C) * 2u; voffB[i] = (unsigned)(Rb * K + C) * 2u; }
    const size_t kstep = (size_t)(BK * 2);
    const size_t hstep = (size_t)HALF * K * 2;
    const size_t tstep = 2 * hstep;
    const unsigned ldsw = (unsigned)wid * 1024u;
    const int aoff = lds_byte(wr * 64 + fr, fq * 8), boff = lds_byte(wc * 32 + fr, fq * 8);
#define PG8_SA(b, h) (((b) * 2 + (h)) * HTB)
#define PG8_SB(b, h) ((4 + (b) * 2 + (h)) * HTB)
#define PG8_STAGE(bufoff, gbase, voff) do { _Pragma("unroll") for (int _i = 0; _i < 2; ++_i) \
        __builtin_amdgcn_global_load_lds((const unsigned*)((const char*)(gbase) + (voff)[_i]), (PG8_LAS unsigned*)(lds + (bufoff) + ldsw + _i * 8192), 16, 0, 0); } while (0)
#define PG8_LDA(dst, b, h) do { _Pragma("unroll") for (int m = 0; m < 4; ++m) _Pragma("unroll") for (int k = 0; k < 2; ++k) dst[m][k] = *(const PG8_LAS bf16x8*)(lds + PG8_SA(b, h) + aoff + m * 2048 + k * 1024); } while (0)
#define PG8_LDB(dst, b, h) do { _Pragma("unroll") for (int n = 0; n < 2; ++n) _Pragma("unroll") for (int k = 0; k < 2; ++k) dst[n][k] = *(const PG8_LAS bf16x8*)(lds + PG8_SB(b, h) + boff + n * 2048 + k * 1024); } while (0)
#define PG8_MMA(ai, bj, At, Bt) do { __builtin_amdgcn_s_setprio(1); _Pragma("unroll") for (int m = 0; m < 4; ++m) _Pragma("unroll") for (int n = 0; n < 2; ++n) _Pragma("unroll") for (int k = 0; k < 2; ++k) \
        acc[ai][bj][m][n] = __builtin_amdgcn_mfma_f32_16x16x32_bf16(Bt[n][k], At[m][k], acc[ai][bj][m][n], 0, 0, 0); __builtin_amdgcn_s_setprio(0); } while (0)
#define PG8_WAIT_V(n) asm volatile("s_waitcnt vmcnt(" #n ")" ::: "memory")
#define PG8_WAIT_L(n) asm volatile("s_waitcnt lgkmcnt(" #n ")" ::: "memory")
#define PG8_BAR __builtin_amdgcn_s_barrier()
#define PG8_SCHED __builtin_amdgcn_sched_barrier(0)
    Unit cur, nxt; int ui = 0;
    if (!S.next(0, cur)) return;
    f32x4 acc[2][2][4][2];
#pragma unroll
    for (int a = 0; a < 2; ++a)
#pragma unroll
        for (int b = 0; b < 2; ++b)
#pragma unroll
            for (int m = 0; m < 4; ++m)
#pragma unroll
                for (int n = 0; n < 2; ++n) acc[a][b][m][n] = (f32x4){0.f, 0.f, 0.f, 0.f};
    bf16x8 At[4][2], B0[2][2], B1[2][2];
    const char* cA = (const char*)g.A + (size_t)cur.pm * tstep; const char* cB = (const char*)g.Bt + (size_t)cur.pn * tstep;
    S.a_ready(cur);
    if constexpr (SP2) {
        PG8_STAGE(PG8_SB(0, 0), cB, voffB); PG8_STAGE(PG8_SB(0, 1), cB + hstep, voffB); PG8_STAGE(PG8_SA(0, 0), cA, voffA); PG8_STAGE(PG8_SA(0, 1), cA + hstep, voffA);
        if (wr == 1) PG8_BAR;
        PG8_WAIT_V(2); PG8_BAR;
        PG8_STAGE(PG8_SB(1, 0), cB + kstep, voffB); PG8_STAGE(PG8_SA(1, 0), cA + kstep, voffA); PG8_STAGE(PG8_SB(1, 1), cB + hstep + kstep, voffB);
        PG8_WAIT_V(6); PG8_BAR;
    } else {
        PG8_STAGE(PG8_SB(0, 0), cB, voffB); PG8_STAGE(PG8_SA(0, 0), cA, voffA); PG8_STAGE(PG8_SB(0, 1), cB + hstep, voffB); PG8_STAGE(PG8_SA(0, 1), cA + hstep, voffA);
        if (wr == 1) PG8_BAR;
        PG8_WAIT_V(4); PG8_BAR;
        PG8_STAGE(PG8_SB(1, 0), cB + kstep, voffB); PG8_STAGE(PG8_SA(1, 0), cA + kstep, voffA); PG8_STAGE(PG8_SB(1, 1), cB + hstep + kstep, voffB);
        PG8_WAIT_V(6); PG8_BAR;
    }
    for (;;) {
        const bool has_next = S.next(ui + 1, nxt);
        const char* nA = has_next ? (const char*)g.A + (size_t)nxt.pm * tstep : cA; const char* nB = has_next ? (const char*)g.Bt + (size_t)nxt.pn * tstep : cB;
        for (int t = 0; t < nt; t += 2) {
            const bool last = (t == nt - 2);
            const char* a1 = cA + (size_t)(t + 1) * kstep;
            const char* a2 = last ? nA : cA + (size_t)(t + 2) * kstep; const char* b2 = last ? nB : cB + (size_t)(t + 2) * kstep;
            const char* a3 = a2 + kstep; const char* b3 = b2 + kstep;
            if (last && has_next) S.a_ready(nxt);
            if constexpr (SP2) {
            PG8_LDB(B0, 0, 0); PG8_LDB(B1, 0, 1); PG8_SCHED; PG8_LDA(At, 0, 0); PG8_STAGE(PG8_SA(1, 1), a1 + hstep, voffA);
            PG8_WAIT_V(8); PG8_WAIT_L(0); PG8_BAR; PG8_MMA(0, 0, At, B0); PG8_MMA(0, 1, At, B1); PG8_BAR; PG8_SCHED;
            PG8_LDA(At, 0, 1); PG8_STAGE(PG8_SB(0, 0), b2, voffB); PG8_STAGE(PG8_SB(0, 1), b2 + hstep, voffB); PG8_STAGE(PG8_SA(0, 0), a2, voffA);
            PG8_WAIT_V(8); PG8_WAIT_L(0); PG8_BAR; PG8_MMA(1, 0, At, B0); PG8_MMA(1, 1, At, B1); PG8_BAR; PG8_SCHED;
            PG8_LDB(B0, 1, 0); PG8_LDB(B1, 1, 1); PG8_SCHED; PG8_LDA(At, 1, 0); PG8_STAGE(PG8_SA(0, 1), a2 + hstep, voffA);
            PG8_WAIT_V(8); PG8_WAIT_L(0); PG8_BAR; PG8_MMA(0, 0, At, B0); PG8_MMA(0, 1, At, B1); PG8_BAR; PG8_SCHED;
            PG8_LDA(At, 1, 1); PG8_STAGE(PG8_SB(1, 0), b3, voffB); PG8_STAGE(PG8_SB(1, 1), b3 + hstep, voffB); PG8_STAGE(PG8_SA(1, 0), a3, voffA);
            PG8_WAIT_V(8); PG8_WAIT_L(0); PG8_BAR; PG8_MMA(1, 0, At, B0); PG8_MMA(1, 1, At, B1); PG8_BAR; PG8_SCHED;
            } else {
            PG8_LDB(B0, 0, 0); PG8_SCHED; PG8_LDA(At, 0, 0); PG8_STAGE(PG8_SA(1, 1), a1 + hstep, voffA);
            PG8_WAIT_L(8); PG8_BAR; PG8_WAIT_L(0); PG8_MMA(0, 0, At, B0); PG8_BAR; PG8_SCHED;
            PG8_LDB(B1, 0, 1); PG8_STAGE(PG8_SB(0, 0), b2, voffB);
            PG8_BAR; PG8_WAIT_L(0); PG8_MMA(0, 1, At, B1); PG8_BAR;
            PG8_LDA(At, 0, 1); PG8_STAGE(PG8_SA(0, 0), a2, voffA);
            PG8_BAR; PG8_WAIT_L(0); PG8_MMA(1, 0, At, B0); PG8_BAR; PG8_SCHED;
            PG8_STAGE(PG8_SB(0, 1), b2 + hstep, voffB);
            PG8_WAIT_V(6); PG8_BAR; PG8_MMA(1, 1, At, B1); PG8_BAR;
            PG8_LDB(B0, 1, 0); PG8_SCHED; PG8_LDA(At, 1, 0); PG8_STAGE(PG8_SA(0, 1), a2 + hstep, voffA);
            PG8_WAIT_L(8); PG8_BAR; PG8_WAIT_L(0); PG8_MMA(0, 0, At, B0); PG8_BAR; PG8_SCHED;
            PG8_LDB(B1, 1, 1); PG8_STAGE(PG8_SB(1, 0), b3, voffB);
            PG8_BAR; PG8_WAIT_L(0); PG8_MMA(0, 1, At, B1); PG8_BAR;
            PG8_LDA(At, 1, 1); PG8_STAGE(PG8_SA(1, 0), a3, voffA);
            PG8_BAR; PG8_WAIT_L(0); PG8_MMA(1, 0, At, B0); PG8_BAR; PG8_SCHED;
            PG8_STAGE(PG8_SB(1, 1), b3 + hstep, voffB);
            PG8_WAIT_V(6); PG8_BAR; PG8_MMA(1, 1, At, B1); PG8_BAR;
            }
        }
        if constexpr (ALIGN_EPI) { if (wr == 0) PG8_BAR; }
        if constexpr (!Epi::AFTER_DRAIN) { E(acc, cur, wr, wc, fr, fq); S.done(cur); }
        if (!has_next) break;
#pragma unroll
        for (int a = 0; a < 2; ++a)
#pragma unroll
            for (int b = 0; b < 2; ++b)
#pragma unroll
                for (int m = 0; m < 4; ++m)
#pragma unroll
                    for (int n = 0; n < 2; ++n) acc[a][b][m][n] = (f32x4){0.f, 0.f, 0.f, 0.f};
        cur = nxt; cA = nA; cB = nB; ++ui;
        if constexpr (ALIGN_EPI) { if (wr == 1) PG8_BAR; }
    }
    PG8_WAIT_V(0);
    if constexpr (!ALIGN_EPI) { if (wr == 0) PG8_BAR; }
    PG8_BAR;
    if constexpr (Epi::AFTER_DRAIN) { E.fused(acc, cur, wr, wc, fr, fq, lds, wid, lane); S.done(cur); }
#undef PG8_SA
#undef PG8_SB
#undef PG8_STAGE
#undef PG8_LDA
#undef PG8_LDB
#undef PG8_MMA
#undef PG8_WAIT_V
#undef PG8_WAIT_L
#undef PG8_BAR
#undef PG8_SCHED
}
}

constexpr int TOK = 16384, DM = 2048, FF = 5632, NIN = 11264, SEQ = 2048;
constexpr float EPS = 1e-6f, LOG2E = 1.4426950408889634f;
constexpr size_t MiB = (size_t)1 << 20;
constexpr size_t WS_CTL = 0;
constexpr size_t WS_WIN = 1 * MiB;
constexpr size_t WS_WA = 1 * MiB, WS_WB = 5 * MiB, WS_WO = 9 * MiB, WS_WPG = 17 * MiB, WS_WPP = 25 * MiB, WS_PB = 26 * MiB;
constexpr size_t WS_WGU = 45 * MiB;
constexpr size_t WS_WD = 89 * MiB;
constexpr size_t WS_XB = 111 * MiB;
constexpr size_t WS_BIG = 175 * MiB;
constexpr size_t WS_END = 527 * MiB;
constexpr size_t BIG_GA = 224 * MiB, BIG_PLE = 176 * MiB;
constexpr int C_SS1 = 0, C_SS2 = 16384, C_SS3 = 32768, C_SS4 = 49152, C_SSP = 65536, C_QUEUE = 81920, C_ZERO_END = 82048;

typedef unsigned short bf16;
#define LAS __attribute__((address_space(3)))
typedef LAS unsigned char* ldsp;
typedef float f32x4 __attribute__((ext_vector_type(4)));
typedef float f32x16 __attribute__((ext_vector_type(16)));
typedef unsigned u32x4 __attribute__((ext_vector_type(4)));
typedef unsigned u32x2 __attribute__((ext_vector_type(2)));
typedef short bf16x8 __attribute__((ext_vector_type(8)));
typedef short s16x4 __attribute__((ext_vector_type(4)));
typedef float f32x2_t __attribute__((ext_vector_type(2)));
typedef __bf16 bf16x2_t __attribute__((ext_vector_type(2)));

template <class T> __device__ __forceinline__ T lds_ld(ldsp p) { return *(const LAS T*)p; }
template <class T> __device__ __forceinline__ void lds_st(ldsp p, T v) { *(LAS T*)p = v; }
__device__ __forceinline__ unsigned cvtpk(float lo, float hi) { f32x2_t v = {lo, hi}; bf16x2_t b = __builtin_convertvector(v, bf16x2_t); return __builtin_bit_cast(unsigned, b); }
__device__ __forceinline__ float bflo(unsigned w) { return __uint_as_float(w << 16); }
__device__ __forceinline__ float bfhi(unsigned w) { return __uint_as_float(w & 0xffff0000u); }
__device__ __forceinline__ float sigm(float x) { return __builtin_amdgcn_rcpf(1.f + __builtin_amdgcn_exp2f(-x * LOG2E)); }
__device__ __forceinline__ int crow(int r, int hi) { return (r & 3) + 8 * (r >> 2) + 4 * hi; }
__device__ __forceinline__ s16x4 tr_ld(ldsp p) { typedef short v4i16_t __attribute__((ext_vector_type(4))); return __builtin_bit_cast(s16x4, __builtin_amdgcn_ds_read_tr16_b64_v4i16((LAS v4i16_t*)p)); }
__device__ __forceinline__ bf16x8 cat4(s16x4 a, s16x4 b) { return (bf16x8){a[0], a[1], a[2], a[3], b[0], b[1], b[2], b[3]}; }
__device__ __forceinline__ bf16x8 pack8(const f32x16& x, int s) { u32x4 p; p[0] = cvtpk(x[8 * s], x[8 * s + 1]); p[1] = cvtpk(x[8 * s + 2], x[8 * s + 3]); p[2] = cvtpk(x[8 * s + 4], x[8 * s + 5]); p[3] = cvtpk(x[8 * s + 6], x[8 * s + 7]); return __builtin_bit_cast(bf16x8, p); }
#define DPP_F(v, ctrl) __builtin_bit_cast(float, __builtin_amdgcn_update_dpp(0, __builtin_bit_cast(int, (v)), (ctrl), 0xf, 0xf, true))
#define MFMA32(a, b, c) __builtin_amdgcn_mfma_f32_32x32x16_bf16((a), (b), (c), 0, 0, 0)

struct EpiSwiglu {
    static constexpr bool PERM = true, AFTER_DRAIN = false;
    bf16* O; const float* ss;
    __device__ __forceinline__ void operator()(const pg8::f32x4 (&acc)[2][2][4][2], const pg8::Unit& u, int wr, int wc, int fr, int fq) const {
        const int col0 = u.pn * 128 + wc * 32 + 8 * fq, row0 = u.pm * 256 + wr * 64 + fr;
        float rsv[2][4];
#pragma unroll
        for (int ai = 0; ai < 2; ++ai)
#pragma unroll
            for (int m = 0; m < 4; ++m) rsv[ai][m] = ss[row0 + ai * 128 + m * 16];
#pragma unroll
        for (int ai = 0; ai < 2; ++ai)
#pragma unroll
            for (int m = 0; m < 4; ++m) {
                const int row = row0 + ai * 128 + m * 16;
                const float rs = rsqrtf(rsv[ai][m] * (1.f / DM) + EPS), c1 = -rs * LOG2E, rs2 = rs * rs;
                u32x4 w;
#pragma unroll
                for (int n = 0; n < 2; ++n) {
                    const pg8::f32x4 g = acc[ai][0][m][n], up = acc[ai][1][m][n];
                    float o4[4];
#pragma unroll
                    for (int k = 0; k < 4; ++k) o4[k] = (g[k] * up[k]) * (rs2 * __builtin_amdgcn_rcpf(1.f + __builtin_amdgcn_exp2f(g[k] * c1)));
                    w[2 * n] = cvtpk(o4[0], o4[1]); w[2 * n + 1] = cvtpk(o4[2], o4[3]);
                }
                *(u32x4*)(O + (size_t)row * FF + col0) = w;
            }
    }
};
struct EpiResid {
    static constexpr bool PERM = true, AFTER_DRAIN = false;
    const float* R; float* X; bf16* XB; float* ssout; float alpha;
    __device__ __forceinline__ void operator()(const pg8::f32x4 (&acc)[2][2][4][2], const pg8::Unit& u, int wr, int wc, int fr, int fq) const {
        const int row0 = u.pm * 256 + wr * 64 + fr, colb = u.pn * 256 + wc * 32 + 8 * fq;
#pragma unroll
        for (int ai = 0; ai < 2; ++ai) {
            pg8::f32x4 rv[4][2][2];
#pragma unroll
            for (int m = 0; m < 4; ++m)
#pragma unroll
                for (int bj = 0; bj < 2; ++bj) { const size_t off = (size_t)(row0 + ai * 128 + m * 16) * DM + colb + bj * 128;
                    rv[m][bj][0] = *(const pg8::f32x4*)(R + off); rv[m][bj][1] = *(const pg8::f32x4*)(R + off + 4); }
#pragma unroll
            for (int m = 0; m < 4; ++m) {
                const int row = row0 + ai * 128 + m * 16;
                float sq = 0.f;
#pragma unroll
                for (int bj = 0; bj < 2; ++bj) {
                    const size_t off = (size_t)row * DM + colb + bj * 128;
                    const pg8::f32x4 v0 = rv[m][bj][0] + acc[ai][bj][m][0] * alpha, v1 = rv[m][bj][1] + acc[ai][bj][m][1] * alpha;
                    *(pg8::f32x4*)(X + off) = v0; *(pg8::f32x4*)(X + off + 4) = v1;
                    u32x4 w; w[0] = cvtpk(v0[0], v0[1]); w[1] = cvtpk(v0[2], v0[3]); w[2] = cvtpk(v1[0], v1[1]); w[3] = cvtpk(v1[2], v1[3]);
                    *(u32x4*)(XB + off) = w;
                    sq += (v0[0] * v0[0] + v0[1] * v0[1]) + (v0[2] * v0[2] + v0[3] * v0[3]) + (v1[0] * v1[0] + v1[1] * v1[1]) + (v1[2] * v1[2] + v1[3] * v1[3]);
                }
                sq += __shfl_xor(sq, 16); sq += __shfl_xor(sq, 32);
                if (fq == 0) atomicAdd(ssout + row, sq);
            }
        }
    }
};
struct EpiProj {
    static constexpr bool PERM = true, AFTER_DRAIN = false;
    bf16* P; bf16* GA; const float* ss;
    __device__ __forceinline__ void operator()(const pg8::f32x4 (&acc)[2][2][4][2], const pg8::Unit& u, int wr, int wc, int fr, int fq) const {
        if (u.pn < 8) {
            bf16* qb_ = P + (size_t)(u.pn >> 2) * TOK * 1024 + (u.pn & 3) * 256 + 64 * wc + 8 * fq;
            const int rowq = u.pm * 256 + wr * 64 + fr;
            float rsq_[2][4];
#pragma unroll
            for (int ai = 0; ai < 2; ++ai)
#pragma unroll
                for (int m = 0; m < 4; ++m) rsq_[ai][m] = ss[rowq + ai * 128 + m * 16];
#pragma unroll
            for (int ai = 0; ai < 2; ++ai)
#pragma unroll
                for (int m = 0; m < 4; ++m) {
                    const int row = rowq + ai * 128 + m * 16;
                    const float rs = rsqrtf(rsq_[ai][m] * (1.f / DM) + EPS);
                    const pg8::f32x4 a0 = acc[ai][0][m][0] * rs, a1 = acc[ai][0][m][1] * rs, b0 = acc[ai][1][m][0] * rs, b1 = acc[ai][1][m][1] * rs;
                    float sq = (a0[0] * a0[0] + a0[1] * a0[1]) + (a0[2] * a0[2] + a0[3] * a0[3]) + (a1[0] * a1[0] + a1[1] * a1[1]) + (a1[2] * a1[2] + a1[3] * a1[3])
                             + (b0[0] * b0[0] + b0[1] * b0[1]) + (b0[2] * b0[2] + b0[3] * b0[3]) + (b1[0] * b1[0] + b1[1] * b1[1]) + (b1[2] * b1[2] + b1[3] * b1[3]);
                    sq += __shfl_xor(sq, 16); sq += __shfl_xor(sq, 32);
                    const float rn = rsqrtf(sq * (1.f / 64.f) + EPS);
                    u32x4 w0, w1;
                    w0[0] = cvtpk(a0[0] * rn, a0[1] * rn); w0[1] = cvtpk(a0[2] * rn, a0[3] * rn); w0[2] = cvtpk(a1[0] * rn, a1[1] * rn); w0[3] = cvtpk(a1[2] * rn, a1[3] * rn);
                    w1[0] = cvtpk(b0[0] * rn, b0[1] * rn); w1[1] = cvtpk(b0[2] * rn, b0[3] * rn); w1[2] = cvtpk(b1[0] * rn, b1[1] * rn); w1[3] = cvtpk(b1[2] * rn, b1[3] * rn);
                    *(u32x4*)(qb_ + (size_t)row * 1024) = w0; *(u32x4*)(qb_ + (size_t)row * 1024 + 32) = w1;
                }
            return;
        }
        const bool gate = u.pn >= 28;
        bf16* base; int ld, colt;
        if (!gate) { base = P + (size_t)(u.pn >> 2) * TOK * 1024; ld = 1024; colt = (u.pn & 3) * 256; }
        else { const int g = u.pn - 28; base = GA + (size_t)(g >> 3) * TOK * 2048; ld = 2048; colt = (g & 7) * 256; }
        colt += wc * 32 + 8 * fq;
        const int grp = u.pn >> 2;
        const int actm = (gate || grp == 4) ? 1 : ((grp == 3 || grp == 6) ? 2 : 0);
        const int row0 = u.pm * 256 + wr * 64 + fr;
        float rsv[2][4];
#pragma unroll
        for (int ai = 0; ai < 2; ++ai)
#pragma unroll
            for (int m = 0; m < 4; ++m) rsv[ai][m] = ss[row0 + ai * 128 + m * 16];
#pragma unroll
        for (int ai = 0; ai < 2; ++ai)
#pragma unroll
            for (int m = 0; m < 4; ++m) {
                const int row = row0 + ai * 128 + m * 16;
                const float rs = rsqrtf(rsv[ai][m] * (1.f / DM) + EPS);
#pragma unroll
                for (int bj = 0; bj < 2; ++bj) {
                    pg8::f32x4 v0 = acc[ai][bj][m][0], v1 = acc[ai][bj][m][1];
                    if (actm == 0) { v0 = v0 * rs; v1 = v1 * rs; }
                    else {
                        const float c1 = -rs * LOG2E, sc = (actm == 2) ? rs : 0.f;
#pragma unroll
                        for (int i = 0; i < 4; ++i) {
                            const float s0 = __builtin_amdgcn_rcpf(1.f + __builtin_amdgcn_exp2f(v0[i] * c1)), s1 = __builtin_amdgcn_rcpf(1.f + __builtin_amdgcn_exp2f(v1[i] * c1));
                            v0[i] = (actm == 2) ? v0[i] * sc * s0 : s0; v1[i] = (actm == 2) ? v1[i] * sc * s1 : s1; }
                    }
                    u32x4 w; w[0] = cvtpk(v0[0], v0[1]); w[1] = cvtpk(v0[2], v0[3]); w[2] = cvtpk(v1[0], v1[1]); w[3] = cvtpk(v1[2], v1[3]);
                    *(u32x4*)(base + (size_t)row * ld + colt + bj * 128) = w;
                }
            }
    }
};
template <bool FIRST> struct EpiMerge {
    static constexpr bool PERM = true, AFTER_DRAIN = false;
    const bf16* G; bf16* Mg;
    __device__ __forceinline__ void operator()(const pg8::f32x4 (&acc)[2][2][4][2], const pg8::Unit& u, int wr, int wc, int fr, int fq) const {
        const int row0 = u.pm * 256 + wr * 64 + fr, colb = u.pn * 256 + wc * 32 + 8 * fq;
#pragma unroll
        for (int ai = 0; ai < 2; ++ai) {
            u32x4 gv[4][2], pv[4][2];
#pragma unroll
            for (int m = 0; m < 4; ++m)
#pragma unroll
                for (int bj = 0; bj < 2; ++bj) { const size_t off = (size_t)(row0 + ai * 128 + m * 16) * DM + colb + bj * 128;
                    gv[m][bj] = *(const u32x4*)(G + off); if (!FIRST) pv[m][bj] = *(const u32x4*)(Mg + off); else pv[m][bj] = (u32x4){0u, 0u, 0u, 0u}; }
#pragma unroll
            for (int m = 0; m < 4; ++m)
#pragma unroll
                for (int bj = 0; bj < 2; ++bj) {
                    const size_t off = (size_t)(row0 + ai * 128 + m * 16) * DM + colb + bj * 128;
                    const u32x4 gw = gv[m][bj];
                    pg8::f32x4 v0 = acc[ai][bj][m][0], v1 = acc[ai][bj][m][1];
                    v0[0] *= bflo(gw[0]); v0[1] *= bfhi(gw[0]); v0[2] *= bflo(gw[1]); v0[3] *= bfhi(gw[1]);
                    v1[0] *= bflo(gw[2]); v1[1] *= bfhi(gw[2]); v1[2] *= bflo(gw[3]); v1[3] *= bfhi(gw[3]);
                    if (!FIRST) { const u32x4 pw = pv[m][bj];
                        v0[0] += bflo(pw[0]); v0[1] += bfhi(pw[0]); v0[2] += bflo(pw[1]); v0[3] += bfhi(pw[1]);
                        v1[0] += bflo(pw[2]); v1[1] += bfhi(pw[2]); v1[2] += bflo(pw[3]); v1[3] += bfhi(pw[3]); }
                    u32x4 w; w[0] = cvtpk(v0[0], v0[1]); w[1] = cvtpk(v0[2], v0[3]); w[2] = cvtpk(v1[0], v1[1]); w[3] = cvtpk(v1[2], v1[3]);
                    *(u32x4*)(Mg + off) = w;
                }
        }
    }
};
struct MergeOrder {
    pg8::StaticOrder so; int nt;
    __device__ __forceinline__ void init(int G_, int c_) { so.init(TOK, DM, G_, c_); nt = (so.nwg > c_) ? (so.nwg - c_ + G_ - 1) / G_ : 0; }
    __device__ __forceinline__ bool next(int i, pg8::Unit& u) const {
        if (i >= 2 * nt) return false;
        const bool second = i >= nt;
        if (!so.next(second ? i - nt : i, u)) return false;
        if (second) { u.pm += TOK / 256; u.pn += DM / 256; }
        return true;
    }
    __device__ __forceinline__ void a_ready(const pg8::Unit&) const {}
    __device__ __forceinline__ void done(const pg8::Unit&) const {}
};
struct EpiMerge2 {
    static constexpr bool PERM = true, AFTER_DRAIN = false;
    const bf16* GA_; const bf16* GB_; bf16* Mg;
    __device__ __forceinline__ void operator()(const pg8::f32x4 (&acc)[2][2][4][2], const pg8::Unit& u, int wr, int wc, int fr, int fq) const {
        const bool second = u.pm >= TOK / 256;
        const int pm = second ? u.pm - TOK / 256 : u.pm, pn = second ? u.pn - DM / 256 : u.pn;
        const bf16* G = second ? GB_ : GA_;
        const int row0 = pm * 256 + wr * 64 + fr, colb = pn * 256 + wc * 32 + 8 * fq;
#pragma unroll
        for (int ai = 0; ai < 2; ++ai) {
            u32x4 gv[4][2], pv[4][2];
#pragma unroll
            for (int m = 0; m < 4; ++m)
#pragma unroll
                for (int bj = 0; bj < 2; ++bj) { const size_t off = (size_t)(row0 + ai * 128 + m * 16) * DM + colb + bj * 128;
                    gv[m][bj] = *(const u32x4*)(G + off); pv[m][bj] = (u32x4){0u, 0u, 0u, 0u}; if (second) pv[m][bj] = *(const u32x4*)(Mg + off); }
#pragma unroll
            for (int m = 0; m < 4; ++m)
#pragma unroll
                for (int bj = 0; bj < 2; ++bj) {
                    const size_t off = (size_t)(row0 + ai * 128 + m * 16) * DM + colb + bj * 128;
                    const u32x4 gw = gv[m][bj], pw = pv[m][bj];
                    pg8::f32x4 v0 = acc[ai][bj][m][0], v1 = acc[ai][bj][m][1];
                    v0[0] = v0[0] * bflo(gw[0]) + bflo(pw[0]); v0[1] = v0[1] * bfhi(gw[0]) + bfhi(pw[0]); v0[2] = v0[2] * bflo(gw[1]) + bflo(pw[1]); v0[3] = v0[3] * bfhi(gw[1]) + bfhi(pw[1]);
                    v1[0] = v1[0] * bflo(gw[2]) + bflo(pw[2]); v1[1] = v1[1] * bfhi(gw[2]) + bfhi(pw[2]); v1[2] = v1[2] * bflo(gw[3]) + bflo(pw[3]); v1[3] = v1[3] * bfhi(gw[3]) + bfhi(pw[3]);
                    u32x4 w; w[0] = cvtpk(v0[0], v0[1]); w[1] = cvtpk(v0[2], v0[3]); w[2] = cvtpk(v1[0], v1[1]); w[3] = cvtpk(v1[2], v1[3]);
                    *(u32x4*)(Mg + off) = w;
                }
        }
    }
};
struct EpiPle {
    static constexpr bool PERM = true, AFTER_DRAIN = false;
    bf16* O; float* ssout;
    __device__ __forceinline__ void operator()(const pg8::f32x4 (&acc)[2][2][4][2], const pg8::Unit& u, int wr, int wc, int fr, int fq) const {
#pragma unroll
        for (int ai = 0; ai < 2; ++ai)
#pragma unroll
            for (int m = 0; m < 4; ++m) {
                const int row = u.pm * 256 + ai * 128 + wr * 64 + m * 16 + fr;
                float sq = 0.f;
#pragma unroll
                for (int bj = 0; bj < 2; ++bj) {
                    const size_t off = (size_t)row * DM + u.pn * 256 + bj * 128 + wc * 32 + 8 * fq;
                    const pg8::f32x4 v0 = acc[ai][bj][m][0], v1 = acc[ai][bj][m][1];
                    u32x4 w; w[0] = cvtpk(v0[0], v0[1]); w[1] = cvtpk(v0[2], v0[3]); w[2] = cvtpk(v1[0], v1[1]); w[3] = cvtpk(v1[2], v1[3]);
                    *(u32x4*)(O + off) = w;
                    sq += (v0[0] * v0[0] + v0[1] * v0[1]) + (v0[2] * v0[2] + v0[3] * v0[3]) + (v1[0] * v1[0] + v1[1] * v1[1]) + (v1[2] * v1[2] + v1[3] * v1[3]);
                }
                sq += __shfl_xor(sq, 16); sq += __shfl_xor(sq, 32);
                if (fq == 0) atomicAdd(ssout + row, sq);
            }
    }
};
struct EpiFinal {
    static constexpr bool PERM = true, AFTER_DRAIN = false;
    float* X; const bf16* PLE; const float* ss4; const float* ssp; const float* gpost;
    __device__ __forceinline__ void operator()(const pg8::f32x4 (&acc)[2][2][4][2], const pg8::Unit& u, int wr, int wc, int fr, int fq) const {
        const int row0 = u.pm * 256 + wr * 64 + fr, colb = u.pn * 256 + wc * 32 + 8 * fq;
        float s4[2][4], sp[2][4]; pg8::f32x4 gp[2][2];
#pragma unroll
        for (int ai = 0; ai < 2; ++ai)
#pragma unroll
            for (int m = 0; m < 4; ++m) { s4[ai][m] = ss4[row0 + ai * 128 + m * 16]; sp[ai][m] = ssp[row0 + ai * 128 + m * 16]; }
#pragma unroll
        for (int bj = 0; bj < 2; ++bj) { gp[bj][0] = *(const pg8::f32x4*)(gpost + colb + bj * 128); gp[bj][1] = *(const pg8::f32x4*)(gpost + colb + bj * 128 + 4); }
#pragma unroll
        for (int ai = 0; ai < 2; ++ai)
#pragma unroll
            for (int mp = 0; mp < 2; ++mp) {
                pg8::f32x4 xv[2][2][2]; u32x4 pl[2][2];
#pragma unroll
                for (int mm = 0; mm < 2; ++mm)
#pragma unroll
                    for (int bj = 0; bj < 2; ++bj) { const size_t off = (size_t)(row0 + ai * 128 + (2 * mp + mm) * 16) * DM + colb + bj * 128;
                        xv[mm][bj][0] = *(const pg8::f32x4*)(X + off); xv[mm][bj][1] = *(const pg8::f32x4*)(X + off + 4); pl[mm][bj] = *(const u32x4*)(PLE + off); }
#pragma unroll
                for (int mm = 0; mm < 2; ++mm) {
                    const int m = 2 * mp + mm;
                    const float rs = rsqrtf(s4[ai][m] * (1.f / DM) + EPS), rp = rsqrtf(sp[ai][m] * (1.f / DM) + EPS);
#pragma unroll
                    for (int bj = 0; bj < 2; ++bj) {
                        const size_t off = (size_t)(row0 + ai * 128 + m * 16) * DM + colb + bj * 128;
                        const u32x4 pw = pl[mm][bj];
                        const pg8::f32x4 g0 = gp[bj][0], g1 = gp[bj][1];
                        pg8::f32x4 x0 = xv[mm][bj][0], x1 = xv[mm][bj][1];
                        const pg8::f32x4 a0 = acc[ai][bj][m][0] * rs, a1 = acc[ai][bj][m][1] * rs;
                        x0[0] += sigm(a0[0]) * (bflo(pw[0]) * rp * g0[0]); x0[1] += sigm(a0[1]) * (bfhi(pw[0]) * rp * g0[1]);
                        x0[2] += sigm(a0[2]) * (bflo(pw[1]) * rp * g0[2]); x0[3] += sigm(a0[3]) * (bfhi(pw[1]) * rp * g0[3]);
                        x1[0] += sigm(a1[0]) * (bflo(pw[2]) * rp * g1[0]); x1[1] += sigm(a1[1]) * (bfhi(pw[2]) * rp * g1[1]);
                        x1[2] += sigm(a1[2]) * (bflo(pw[3]) * rp * g1[2]); x1[3] += sigm(a1[3]) * (bfhi(pw[3]) * rp * g1[3]);
                        *(pg8::f32x4*)(X + off) = x0; *(pg8::f32x4*)(X + off + 4) = x1;
                    }
                }
            }
    }
};

__device__ __forceinline__ float wave_sum(float v) {
#pragma unroll
    for (int o = 1; o < 64; o <<= 1) v += __shfl_xor(v, o);
    return v;
}
__device__ __forceinline__ void transpose_item(const float* __restrict__ W, int K, int N, const float* __restrict__ gain, bf16* WT, int mode, ldsp scr, int item, int lane) {
    const int nblk = N / 32, kb = item / nblk, nb = item % nblk, k0 = 64 * kb, n0 = 32 * nb;
    int r0;
    if (mode == 0) r0 = n0;
    else if (mode == 3) r0 = (n0 < 2048) ? ((n0 & ~255) + ((n0 >> 5) & 1) * 128 + ((n0 >> 6) & 3) * 32) : n0;
    else r0 = (n0 >> 7) * 256 + (mode == 2 ? 128 : 0) + (n0 & 127);
    float tv[32];
#pragma unroll
    for (int i = 0; i < 32; ++i) tv[i] = __builtin_nontemporal_load(&W[(size_t)(k0 + 2 * i + (lane >> 5)) * N + n0 + (lane & 31)]);
#pragma unroll
    for (int i = 0; i < 32; ++i) { const int kk = 2 * i + (lane >> 5); float v = tv[i]; if (gain) v *= gain[k0 + kk]; lds_st<float>(scr + 4 * (kk * 33 + (lane & 31)), v); }
    asm volatile("s_waitcnt lgkmcnt(0)" ::: "memory");
    const int c = lane & 7;
#pragma unroll
    for (int j = 0; j < 4; ++j) { const int n = (lane >> 3) + 8 * j; ldsp s = scr + 4 * ((8 * c) * 33 + n);
        u32x4 o; o[0] = cvtpk(lds_ld<float>(s), lds_ld<float>(s + 132)); o[1] = cvtpk(lds_ld<float>(s + 264), lds_ld<float>(s + 396));
        o[2] = cvtpk(lds_ld<float>(s + 528), lds_ld<float>(s + 660)); o[3] = cvtpk(lds_ld<float>(s + 792), lds_ld<float>(s + 924));
        *(u32x4*)(WT + (size_t)(r0 + n) * K + k0 + 8 * c) = o; }
    asm volatile("s_waitcnt lgkmcnt(0)" ::: "memory");
}
#define RLX_AGENT __ATOMIC_RELAXED, __HIP_MEMORY_SCOPE_AGENT
#define XB_TMO      128
#define XB_XCNT(j)  (256  + 64 * (j))
#define XB_XSUB(j)  (1280 + 64 * (j))
#define XB_XGEN(j)  (2304 + 64 * (j))
#define XB_TOP      3328
#define XB_TOPGEN   3392
#define XCD_BAR_WORDS 3456
#define XB_SPIN_CAP (1u << 18)

__device__ __forceinline__ unsigned xb_ld(unsigned* p)              { return __hip_atomic_load(p, __ATOMIC_RELAXED, __HIP_MEMORY_SCOPE_AGENT); }
__device__ __forceinline__ unsigned xb_add(unsigned* p, unsigned v) { return __hip_atomic_fetch_add(p, v, __ATOMIC_RELAXED, __HIP_MEMORY_SCOPE_AGENT); }
__device__ __forceinline__ unsigned xb_xcc_id() { return (unsigned)__builtin_amdgcn_s_getreg((3 << 11) | 20) & 0xFu; }
#define XB_SPIN(cond, bar) do { unsigned _sp = 0; while (cond) { __builtin_amdgcn_s_sleep(1); \
    if ((++_sp & 255u) == 0u) { if (xb_ld(&(bar)[XB_TMO])) break; if (_sp > XB_SPIN_CAP) { atomicAdd(&(bar)[XB_TMO], 1u); break; } } } } while (0)

struct XcdBarrier {
    unsigned* bar; unsigned x;
    volatile LAS unsigned* st;
};

__device__ __forceinline__ XcdBarrier xcd_barrier_post(unsigned* bar, volatile LAS unsigned* st) {
    XcdBarrier b; b.bar = bar; b.x = xb_xcc_id(); b.st = st;
    if (threadIdx.x == 0) (void)xb_add(&bar[XB_XCNT(b.x)], 1u);
    return b;
}
__device__ __forceinline__ void xcd_barrier_complete(unsigned* bar, unsigned x, unsigned& nloc, unsigned& nx) {
    const unsigned G = gridDim.x * gridDim.y * gridDim.z;
    unsigned sum, cnt, mine, sp = 0u;
    for (;;) {
        sum = 0u; cnt = 0u; mine = 0u;
#pragma unroll
        for (unsigned j = 0; j < 16; ++j) { const unsigned c = xb_ld(&bar[XB_XCNT(j)]); sum += c; cnt += (c > 0u) ? 1u : 0u; mine = (j == x) ? c : mine; }
        if (sum == G) break;
        __builtin_amdgcn_s_sleep(1);
        if ((++sp & 255u) == 0u) { if (xb_ld(&bar[XB_TMO])) break; if (sp > XB_SPIN_CAP) { atomicAdd(&bar[XB_TMO], 1u); break; } }
    }
    nloc = mine > 0u ? mine : 1u; nx = cnt > 0u ? cnt : 1u;
}

__device__ __forceinline__ void xcd_barrier(const XcdBarrier& b) {
    asm volatile("s_waitcnt vmcnt(0)" ::: "memory");
    __syncthreads();
    if (threadIdx.x == 0) {
        unsigned* bar = b.bar;
        __builtin_amdgcn_s_waitcnt(0);
        unsigned nloc = b.st[0], nx = b.st[1];
        if (nloc == 0u) { xcd_barrier_complete(bar, b.x, nloc, nx); b.st[0] = nloc; b.st[1] = nx; }
        const unsigned old = xb_add(&bar[XB_XSUB(b.x)], 1u);
        const unsigned gen = old / nloc;
        if (old + 1u == (gen + 1u) * nloc) {
            __builtin_amdgcn_fence(__ATOMIC_RELEASE, "agent");
            asm volatile("s_waitcnt vmcnt(0)" ::: "memory");
            const unsigned og = xb_add(&bar[XB_TOP], 1u);
            const unsigned tg = og / nx;
            if (og + 1u == (tg + 1u) * nx) xb_add(&bar[XB_TOPGEN], 1u);
            else XB_SPIN(xb_ld(&bar[XB_TOPGEN]) == tg, bar);
            __builtin_amdgcn_fence(__ATOMIC_ACQUIRE, "agent");
            xb_add(&bar[XB_XGEN(b.x)], 1u);
            asm volatile("s_waitcnt vmcnt(0)" ::: "memory");
        } else {
            XB_SPIN(xb_ld(&bar[XB_XGEN(b.x)]) == gen, bar);
            __builtin_amdgcn_fence(__ATOMIC_ACQUIRE, "agent");
            asm volatile("s_waitcnt vmcnt(0)" ::: "memory");
        }
    }
    __syncthreads();
}

constexpr int A_KP = 144, A_KT = 64 * A_KP, A_VP = 320, A_VT = 64 * A_VP, A_STAGE = 2 * A_KT + A_VT;
constexpr int A_TAB = 131072, A_WSF = A_TAB + 512, A_QSLOT = A_WSF + 1024;
constexpr int LDS_BYTES = 147456;
static_assert(2 * A_STAGE <= 131072 && A_QSLOT + 64 <= LDS_BYTES, "attention LDS map");

__device__ __forceinline__ void attn_unit(ldsp L, int bh, int qb, const bf16* __restrict__ dq, const bf16* __restrict__ dk, const bf16* __restrict__ dv, bf16* __restrict__ ya,
                                          const float* __restrict__ qn, const float* __restrict__ kn, const float* __restrict__ relb, const float* __restrict__ subln, float lam) {
    const int tid = threadIdx.x, lane = tid & 63, r32 = lane & 31, hi = lane >> 5, w = __builtin_amdgcn_readfirstlane(tid >> 6), j = w >> 2, qs = w & 3;
    const int b = bh >> 3, h = bh & 7, q0 = qb * 128, qrow0 = q0 + 32 * qs;
    const size_t tok0 = (size_t)b * SEQ;
    if (tid < 128) { const int d = tid; int bk = d;
        if (d >= 16) { bk = 16 + (int)(logf((float)d / 16.f) / 2.0794415416798357f * 16.f); bk = bk > 31 ? 31 : bk; }
        lds_st<float>(L + A_TAB + 4 * d, (relb[bk * 8 + h] - relb[31 * 8 + h]) * LOG2E); }
    const int kr = tid >> 3, c8 = tid & 7;
    const bf16* gk = dk + (tok0 + kr) * 1024 + h * 128 + 8 * c8;
    const bf16* gv = dv + (tok0 + kr) * 1024 + h * 128 + 8 * c8;
    u32x4 k0r = *(const u32x4*)gk, k1r = *(const u32x4*)(gk + 64), v0r = *(const u32x4*)gv, v1r = *(const u32x4*)(gv + 64);
    bf16x8 qr[4];
    { const bf16* qp = dq + (tok0 + qrow0 + r32) * 1024 + h * 128 + j * 64 + hi * 8;
      u32x4 raw[4];
#pragma unroll
      for (int d0 = 0; d0 < 4; ++d0) raw[d0] = *(const u32x4*)(qp + 16 * d0);
      const float rs = 0.125f * LOG2E;
#pragma unroll
      for (int d0 = 0; d0 < 4; ++d0) { u32x4 p;
#pragma unroll
          for (int i = 0; i < 4; ++i) { const int d = 16 * d0 + 8 * hi + 2 * i;
              p[i] = cvtpk(bflo(raw[d0][i]) * rs * qn[d] * kn[d], bfhi(raw[d0][i]) * rs * qn[d + 1] * kn[d + 1]); }
          qr[d0] = __builtin_bit_cast(bf16x8, p); } }
#define A_LOAD(t) do { const size_t o_ = (size_t)(t) * 64 * 1024; k0r = *(const u32x4*)(gk + o_); k1r = *(const u32x4*)(gk + o_ + 64); v0r = *(const u32x4*)(gv + o_); v1r = *(const u32x4*)(gv + o_ + 64); } while (0)
#define A_STORE(buf) do { ldsp s_ = L + (buf) * A_STAGE; lds_st<u32x4>(s_ + kr * A_KP + c8 * 16, k0r); lds_st<u32x4>(s_ + A_KT + kr * A_KP + c8 * 16, k1r); \
        lds_st<u32x4>(s_ + 2 * A_KT + kr * A_VP + c8 * 16, v0r); lds_st<u32x4>(s_ + 2 * A_KT + kr * A_VP + 128 + c8 * 16, v1r); } while (0)
    const int NT = 2 * qb + 2;
    A_STORE(0);
    A_LOAD(1);
    __syncthreads();
    f32x16 o[4]; o[0] = f32x16{}; o[1] = f32x16{}; o[2] = f32x16{}; o[3] = f32x16{};
    f32x16 lacc = f32x16{};
    const bf16x8 ones = (bf16x8){0x3F80, 0x3F80, 0x3F80, 0x3F80, 0x3F80, 0x3F80, 0x3F80, 0x3F80};
    const ldsp wsf = L + A_WSF + w * 128;
    const int qpos = qrow0 + r32;
    for (int t = 0; t < NT; ++t) {
        if (t + 1 < NT) A_STORE((t + 1) & 1);
        if (t + 2 < NT) A_LOAD(t + 2);
        const int kb = 64 * t;
        if (kb <= qrow0 + 31) {
            const ldsp Kj = L + (t & 1) * A_STAGE + j * A_KT + r32 * A_KP + hi * 16;
            f32x16 p0 = f32x16{}, p1 = f32x16{};
            __builtin_amdgcn_s_setprio(1);
#pragma unroll
            for (int d0 = 0; d0 < 4; ++d0) { const bf16x8 a0 = lds_ld<bf16x8>(Kj + d0 * 32), a1 = lds_ld<bf16x8>(Kj + 32 * A_KP + d0 * 32);
                p0 = MFMA32(a0, qr[d0], p0); p1 = MFMA32(a1, qr[d0], p1); }
            __builtin_amdgcn_s_setprio(0);
            if (kb + 63 + 128 > qrow0) {
#pragma unroll
                for (int r = 0; r < 16; ++r) { const int d = qpos - (kb + crow(r, hi)), d2 = d - 32;
                    const float b0 = lds_ld<float>(L + A_TAB + 4 * (d < 0 ? 0 : (d > 127 ? 127 : d))), b1 = lds_ld<float>(L + A_TAB + 4 * (d2 < 0 ? 0 : (d2 > 127 ? 127 : d2)));
                    p0[r] = d < 0 ? -1e30f : p0[r] + b0; p1[r] = d2 < 0 ? -1e30f : p1[r] + b1; }
            }
#pragma unroll
            for (int r = 0; r < 16; ++r) { p0[r] = __builtin_amdgcn_exp2f(p0[r]); p1[r] = __builtin_amdgcn_exp2f(p1[r]); }
            bf16x8 pa[4]; pa[0] = pack8(p0, 0); pa[1] = pack8(p0, 1); pa[2] = pack8(p1, 0); pa[3] = pack8(p1, 1);
            lacc = MFMA32(pa[0], ones, lacc); lacc = MFMA32(pa[1], ones, lacc); lacc = MFMA32(pa[2], ones, lacc); lacc = MFMA32(pa[3], ones, lacc);
            const ldsp vbase = L + (t & 1) * A_STAGE + 2 * A_KT + (4 * hi + ((lane & 15) >> 2)) * A_VP + (16 * ((lane >> 4) & 1) + 4 * (lane & 3)) * 2;
#pragma unroll
            for (int s = 0; s < 4; ++s)
#pragma unroll
                for (int vb = 0; vb < 4; ++vb) { const s16x4 lo = tr_ld(vbase + s * 16 * A_VP + vb * 64), hh = tr_ld(vbase + s * 16 * A_VP + 8 * A_VP + vb * 64);
                    o[vb] = MFMA32(pa[s], cat4(lo, hh), o[vb]); }
        }
        __syncthreads();
    }
#undef A_LOAD
#undef A_STORE
#pragma unroll
    for (int g = 0; g < 4; ++g) {
#pragma unroll
        for (int i = 0; i < 4; ++i) { const float inv = __builtin_amdgcn_rcpf(lacc[4 * g + i]);
#pragma unroll
            for (int vb = 0; vb < 4; ++vb) lds_st<float>(L + j * 65536 + ((qs * 32 + 8 * g + 4 * hi + i) * 128 + 32 * vb + r32) * 4, o[vb][4 * g + i] * inv); } }
    __syncthreads();
    { const int row = tid >> 2, qd = tid & 3; const ldsp e0 = L + (row * 128 + 32 * qd) * 4;
      float d[32]; float ssq = 0.f;
#pragma unroll
      for (int i = 0; i < 8; ++i) { const f32x4 a = lds_ld<f32x4>(e0 + 16 * i), c = lds_ld<f32x4>(e0 + 65536 + 16 * i);
#pragma unroll
          for (int k = 0; k < 4; ++k) { const float x = a[k] - lam * c[k]; d[4 * i + k] = x; ssq += x * x; } }
      ssq += DPP_F(ssq, 0xB1); ssq += DPP_F(ssq, 0x4E);
      const float rs = rsqrtf(ssq * (1.f / 128.f) + EPS) * 0.8f;
      bf16* yp = ya + (tok0 + q0 + row) * 1024 + h * 128 + 32 * qd;
#pragma unroll
      for (int i = 0; i < 4; ++i) { u32x4 wv;
#pragma unroll
          for (int k = 0; k < 4; ++k) { const int c = 8 * i + 2 * k; wv[k] = cvtpk(d[c] * rs * subln[32 * qd + c], d[c + 1] * rs * subln[32 * qd + c + 1]); }
          *(u32x4*)(yp + 8 * i) = wv; } }
    __syncthreads();
}

constexpr int H_QP = 272, H_TP = 80, H_VP = 320;
constexpr int H_QT = 0, H_KT = 32 * H_QP, H_KTT = 2 * 32 * H_QP, H_V = H_KTT + 128 * H_TP, H_DEC = H_V + 32 * H_VP, H_O = H_DEC + 512, H_BUF = H_O + 32 * 512;
static_assert(2 * H_BUF <= 131072, "hgrn LDS map");

__device__ __forceinline__ void hgrn_unit(ldsp L, int bh, const bf16* __restrict__ hq, const bf16* __restrict__ hf, const bf16* __restrict__ hv, const bf16* __restrict__ hg, bf16* __restrict__ yb,
                                          const float* __restrict__ lbl, const float* __restrict__ gnorm) {
    const int tid = threadIdx.x, lane = tid & 63, r32 = lane & 31, hi = lane >> 5, w = __builtin_amdgcn_readfirstlane(tid >> 6);
    const int b = bh >> 3, h = bh & 7;
    const size_t tok0 = (size_t)b * SEQ;
    const bool prep = w >= 4;
    const int pt = tid & 255, cpl = lane & 15, tq = lane >> 4, k0 = 2 * (16 * (w & 3) + cpl);
    const float lb0 = sigm(lbl[h * 128 + k0] - lbl[1024 + h * 128 + k0]), lb1 = sigm(lbl[h * 128 + k0 + 1] - lbl[1024 + h * 128 + k0 + 1]);
    const int vrow = pt >> 3, vc8 = pt & 7;
    f32x16 S[4]; S[0] = f32x16{}; S[1] = f32x16{}; S[2] = f32x16{}; S[3] = f32x16{};
    const int vb = w & 3;
    unsigned qw[8], fw[8]; u32x4 v0r = {0u, 0u, 0u, 0u}, v1r = {0u, 0u, 0u, 0u}, g0r = {0u, 0u, 0u, 0u}, g1r = {0u, 0u, 0u, 0u};
#pragma unroll
    for (int i = 0; i < 8; ++i) { qw[i] = 0u; fw[i] = 0u; }
    auto do_load = [&](int c) {
        const size_t base = (tok0 + 32 * c + 8 * tq) * 1024 + h * 128 + k0;
#pragma unroll
        for (int i = 0; i < 8; ++i) { qw[i] = *(const unsigned*)(hq + base + (size_t)i * 1024); fw[i] = *(const unsigned*)(hf + base + (size_t)i * 1024); }
        const bf16* vsrc = hv + (tok0 + 32 * c + vrow) * 1024 + h * 128 + 8 * vc8;
        v0r = *(const u32x4*)vsrc; v1r = *(const u32x4*)(vsrc + 64);
    };
    auto do_loadg = [&](int c) {
        const size_t off = (tok0 + 32 * c + (pt >> 3)) * 1024 + h * 128 + 16 * (pt & 7);
        g0r = *(const u32x4*)(hg + off); g1r = *(const u32x4*)(hg + off + 8);
    };
    auto do_prep = [&](int c) {
        const ldsp B = L + (c & 1) * H_BUF;
        const u32x4 v0 = v0r, v1 = v1r;
        float qt[2][8], kt[2][8];
#pragma unroll
        for (int ch = 0; ch < 2; ++ch) {
            const float lb = ch ? lb1 : lb0;
            float P = 1.f, Pl[8], kk[8];
#pragma unroll
            for (int i = 0; i < 8; ++i) { const float sg = ch ? bfhi(fw[i]) : bflo(fw[i]); const float f = lb + (1.f - lb) * sg; P *= f; Pl[i] = P; kk[i] = (1.f - lb) * (1.f - sg); }
            const float T0 = __shfl(P, cpl), T1 = __shfl(P, 16 + cpl), T2 = __shfl(P, 32 + cpl), T3 = __shfl(P, 48 + cpl);
            const float pre = tq == 0 ? 1.f : (tq == 1 ? T0 : (tq == 2 ? T0 * T1 : T0 * T1 * T2));
            if (tq == 0) lds_st<float>(B + H_DEC + 4 * (k0 + ch), (T0 * T1) * (T2 * T3));
#pragma unroll
            for (int i = 0; i < 8; ++i) { const float Pt = pre * Pl[i]; const float qv = ch ? bfhi(qw[i]) : bflo(qw[i]);
                qt[ch][i] = qv * Pt; kt[ch][i] = kk[i] * __builtin_amdgcn_rcpf(fmaxf(Pt, 1e-30f)); }
        }
#pragma unroll
        for (int i = 0; i < 8; ++i) { lds_st<unsigned>(B + H_QT + (8 * tq + i) * H_QP + k0 * 2, cvtpk(qt[0][i], qt[1][i])); lds_st<unsigned>(B + H_KT + (8 * tq + i) * H_QP + k0 * 2, cvtpk(kt[0][i], kt[1][i])); }
#pragma unroll
        for (int ch = 0; ch < 2; ++ch) { u32x4 t4; t4[0] = cvtpk(kt[ch][0], kt[ch][1]); t4[1] = cvtpk(kt[ch][2], kt[ch][3]); t4[2] = cvtpk(kt[ch][4], kt[ch][5]); t4[3] = cvtpk(kt[ch][6], kt[ch][7]);
            lds_st<u32x4>(B + H_KTT + (k0 + ch) * H_TP + 16 * tq, t4); }
        lds_st<u32x4>(B + H_V + vrow * H_VP + vc8 * 16, v0); lds_st<u32x4>(B + H_V + vrow * H_VP + 128 + vc8 * 16, v1);
    };
    auto do_final = [&](int c) {
        const ldsp Ob = L + (c & 1) * H_BUF + H_O;
        const int t = pt >> 3, v0 = 16 * (pt & 7);
        float ov[16]; float ssq = 0.f;
#pragma unroll
        for (int i = 0; i < 4; ++i) { const f32x4 a = lds_ld<f32x4>(Ob + (t * 128 + v0 + 4 * i) * 4);
#pragma unroll
            for (int k = 0; k < 4; ++k) { ov[4 * i + k] = a[k]; ssq += a[k] * a[k]; } }
        ssq += DPP_F(ssq, 0xB1); ssq += DPP_F(ssq, 0x4E); ssq += DPP_F(ssq, 0x141);
        const float rs = rsqrtf(ssq * (1.f / 128.f) + EPS);
        const size_t off = (tok0 + 32 * c + t) * 1024 + h * 128 + v0;
        const u32x4 g0 = g0r, g1 = g1r;
        u32x4 w0, w1;
#pragma unroll
        for (int k = 0; k < 4; ++k) { const float a = bflo(g0[k]), c2 = bfhi(g0[k]), a1 = bflo(g1[k]), c1 = bfhi(g1[k]);
            w0[k] = cvtpk(ov[2 * k] * rs * gnorm[v0 + 2 * k] * a, ov[2 * k + 1] * rs * gnorm[v0 + 2 * k + 1] * c2);
            w1[k] = cvtpk(ov[8 + 2 * k] * rs * gnorm[v0 + 8 + 2 * k] * a1, ov[8 + 2 * k + 1] * rs * gnorm[v0 + 8 + 2 * k + 1] * c1); }
        *(u32x4*)(yb + off) = w0; *(u32x4*)(yb + off + 8) = w1;
    };
    auto do_mfma = [&](int c) {
        const ldsp B = L + (c & 1) * H_BUF;
        const ldsp Qt = B + H_QT + r32 * H_QP, Kt = B + H_KT + r32 * H_QP;
        f32x16 D = f32x16{};
#pragma unroll
        for (int kk = 0; kk < 8; ++kk) { const bf16x8 a = lds_ld<bf16x8>(Kt + (16 * kk + 8 * hi) * 2), bq = lds_ld<bf16x8>(Qt + (16 * kk + 8 * hi) * 2); D = MFMA32(a, bq, D); }
#pragma unroll
        for (int r = 0; r < 16; ++r) if (crow(r, hi) > r32) D[r] = 0.f;
        const bf16x8 aD0 = pack8(D, 0), aD1 = pack8(D, 1);
        const ldsp vbase = B + H_V + ((lane & 15) >> 2) * H_VP + (32 * vb + 16 * ((lane >> 4) & 1) + 4 * (lane & 3)) * 2;
        f32x16 o = f32x16{};
        { const s16x4 lo = tr_ld(vbase + (4 * hi) * H_VP), hh = tr_ld(vbase + (8 + 4 * hi) * H_VP); o = MFMA32(aD0, cat4(lo, hh), o); }
        { const s16x4 lo = tr_ld(vbase + (16 + 4 * hi) * H_VP), hh = tr_ld(vbase + (24 + 4 * hi) * H_VP); o = MFMA32(aD1, cat4(lo, hh), o); }
#pragma unroll
        for (int kb = 0; kb < 4; ++kb)
#pragma unroll
            for (int s2 = 0; s2 < 2; ++s2) { const u32x2 q1 = lds_ld<u32x2>(Qt + (32 * kb + 16 * s2 + 4 * hi) * 2), q2 = lds_ld<u32x2>(Qt + (32 * kb + 16 * s2 + 8 + 4 * hi) * 2);
                const u32x4 qa = {q1[0], q1[1], q2[0], q2[1]};
                o = MFMA32(__builtin_bit_cast(bf16x8, qa), pack8(S[kb], s2), o); }
        const ldsp Ob = B + H_O;
#pragma unroll
        for (int r = 0; r < 16; ++r) lds_st<float>(Ob + (crow(r, hi) * 128 + 32 * vb + r32) * 4, o[r]);
#pragma unroll
        for (int kb = 0; kb < 4; ++kb) {
#pragma unroll
            for (int s2 = 0; s2 < 2; ++s2) { const bf16x8 ka = lds_ld<bf16x8>(B + H_KTT + (32 * kb + r32) * H_TP + (16 * s2 + 8 * hi) * 2);
                const s16x4 lo = tr_ld(vbase + (16 * s2 + 8 * hi) * H_VP), hh = tr_ld(vbase + (16 * s2 + 8 * hi + 4) * H_VP);
                S[kb] = MFMA32(ka, cat4(lo, hh), S[kb]); }
#pragma unroll
            for (int g = 0; g < 4; ++g) { const f32x4 d4 = lds_ld<f32x4>(B + H_DEC + (32 * kb + 8 * g + 4 * hi) * 4);
#pragma unroll
                for (int i = 0; i < 4; ++i) S[kb][4 * g + i] *= d4[i]; }
        }
    };
    if (prep) { do_load(0); do_prep(0); do_load(1); }
    __syncthreads();
    for (int c = 0; c < 64; ++c) {
        if (prep) {
            if (c + 1 < 64) do_prep(c + 1);
            if (c + 2 < 64) do_load(c + 2);
            if (c > 0) do_final(c - 1);
            do_loadg(c);
        }
        else do_mfma(c);
        __syncthreads();
    }
    if (prep) do_final(63);
    __syncthreads();
}

struct Args { const float* in[29]; float* out; unsigned char* ws; int ph_lo, ph_hi; };
constexpr int N_PHASES = 10;
constexpr size_t WS_BAR = 512 * 1024;
constexpr int LDS_BARST = 133120;

__global__ void __launch_bounds__(512, 2) fwd_megakernel(Args a) {
    extern __shared__ __attribute__((aligned(16))) unsigned char lds_raw[];
    const ldsp L = (ldsp)lds_raw;
    PG8_LAS unsigned char* const LG = (PG8_LAS unsigned char*)lds_raw;
    cg::grid_group grid = cg::this_grid();
    const int tid = threadIdx.x, lane = tid & 63, wave = __builtin_amdgcn_readfirstlane(tid >> 6);
    const int G = gridDim.x, bx = blockIdx.x;
    unsigned char* ws = a.ws;
    float* ctl = (float*)(ws + WS_CTL);
    bf16* Win_t = (bf16*)(ws + WS_WIN); bf16* Wgu_t = (bf16*)(ws + WS_WGU); bf16* Wd_t = (bf16*)(ws + WS_WD);
    bf16* Wa_t = (bf16*)(ws + WS_WA); bf16* Wb_t = (bf16*)(ws + WS_WB); bf16* Wo_t = (bf16*)(ws + WS_WO); bf16* Wpg_t = (bf16*)(ws + WS_WPG); bf16* Wpp_t = (bf16*)(ws + WS_WPP); bf16* PB = (bf16*)(ws + WS_PB);
    bf16* XB = (bf16*)(ws + WS_XB); bf16* YA = XB; bf16* YB = XB + (size_t)TOK * 1024;
    bf16* ACT = (bf16*)(ws + WS_BIG); bf16* PROJ = ACT; bf16* GAB = (bf16*)(ws + WS_BIG + BIG_GA); bf16* MERGED = ACT; bf16* PLE = (bf16*)(ws + WS_BIG + BIG_PLE);
    float* OUT = a.out;
    const int lo = a.ph_lo, hi_ = a.ph_hi;
    if (tid < 4) lds_st<unsigned>(L + LDS_BARST + 4 * tid, 0u);
    __syncthreads();
    XcdBarrier xbar; xbar.bar = (unsigned*)(ws + WS_BAR); xbar.x = 0; xbar.st = nullptr;
    if (hi_ - lo > 1) xbar = xcd_barrier_post((unsigned*)(ws + WS_BAR), (volatile LAS unsigned*)(L + LDS_BARST));
    if (lo < 0) grid.sync();
#define IN(k) (lo <= (k) && (k) < hi_)
#define SEAM(k) do { if (IN(k) && IN((k) + 1)) xcd_barrier(xbar); } while (0)
#define RUN_GEMM(EPI, Aptr, Bptr, N_, K_, Eobj) do { pg8::Gemm g_{(const pg8::bf16_t*)(Aptr), (const pg8::bf16_t*)(Bptr), TOK, (N_), (K_)}; pg8::StaticOrder S_; S_.init(TOK, (N_), G, bx); \
        pg8::gemm_phase<EPI, pg8::StaticOrder, true, true>(LG, g_, S_, Eobj); } while (0)

    if (IN(0)) {
        const int gw = bx * 8 + wave, NGW = G * 8;
        for (int i = bx * 512 + tid; i < C_ZERO_END - C_SS2; i += G * 512) ctl[C_SS2 + i] = 0.f;
        const ldsp scr = L + wave * 16384;
        constexpr int I_GU = (DM / 64) * (FF / 32), I_D = (FF / 64) * (DM / 32), I_IN = (DM / 64) * (NIN / 32);
        for (int it = gw; it < 2 * I_GU + I_D + I_IN; it += NGW) {
            int r = it;
            if (r < I_GU) { transpose_item(a.in[3], DM, FF, a.in[2], Wgu_t, 1, scr, r, lane); continue; } r -= I_GU;
            if (r < I_GU) { transpose_item(a.in[4], DM, FF, a.in[2], Wgu_t, 2, scr, r, lane); continue; } r -= I_GU;
            if (r < I_D) { transpose_item(a.in[5], FF, DM, nullptr, Wd_t, 0, scr, r, lane); continue; } r -= I_D;
            transpose_item(a.in[7], DM, NIN, a.in[6], Win_t, 3, scr, r, lane);
        }
        for (int m = gw; m < TOK; m += NGW) {
            const f32x4* xr = (const f32x4*)(a.in[0] + (size_t)m * DM) + lane;
            f32x4 v[8]; float s = 0.f;
#pragma unroll
            for (int j = 0; j < 8; ++j) { v[j] = __builtin_nontemporal_load(xr + 64 * j); s += (v[j][0] * v[j][0] + v[j][1] * v[j][1]) + (v[j][2] * v[j][2] + v[j][3] * v[j][3]); }
            s = wave_sum(s);
            if (lane == 0) ctl[C_SS1 + m] = s;
            u32x2* o8 = (u32x2*)(XB + (size_t)m * DM) + lane;
#pragma unroll
            for (int j = 0; j < 8; ++j) { u32x2 w2; w2[0] = cvtpk(v[j][0], v[j][1]); w2[1] = cvtpk(v[j][2], v[j][3]); o8[64 * j] = w2; }
        }
    }
    SEAM(0);
    if (IN(1)) { EpiSwiglu E{ACT, ctl + C_SS1}; RUN_GEMM(EpiSwiglu, XB, Wgu_t, 2 * FF, DM, E); }
    SEAM(1);
    if (IN(2)) { EpiResid E{a.in[0], OUT, XB, ctl + C_SS2, 0.5f}; RUN_GEMM(EpiResid, ACT, Wd_t, DM, FF, E); }
    SEAM(2);
    if (IN(3)) { EpiProj E{PROJ, GAB, ctl + C_SS2}; RUN_GEMM(EpiProj, XB, Win_t, NIN, DM, E); }
    SEAM(3);
    if (IN(4)) {
        const size_t PS = (size_t)TOK * 1024;
        if (bx < 64 && G > 64) {
            hgrn_unit(L, bx, PROJ + 3 * PS, PROJ + 4 * PS, PROJ + 5 * PS, PROJ + 6 * PS, YB, a.in[16], a.in[17]);
        } else {
            if (G <= 64) { for (int u = bx; u < 64; u += G) hgrn_unit(L, u, PROJ + 3 * PS, PROJ + 4 * PS, PROJ + 5 * PS, PROJ + 6 * PS, YB, a.in[16], a.in[17]); }
            const int nb0 = (G > 64) ? 64 : 0;
            const int gw = (bx - nb0) * 8 + wave, NGW = (G - nb0) * 8;
            const ldsp scr = L + wave * 16384;
            constexpr int I_A = (1024 / 64) * (DM / 32), I_O = (DM / 64) * (DM / 32), I_PP = (256 / 64) * (DM / 32), I_GU = (DM / 64) * (FF / 32), I_D = (FF / 64) * (DM / 32);
            for (int it = gw; it < 2 * I_A + 2 * I_O + I_PP + 2 * I_GU + I_D; it += NGW) {
                int r = it;
                if (r < I_A) { transpose_item(a.in[18], 1024, DM, nullptr, Wa_t, 0, scr, r, lane); continue; } r -= I_A;
                if (r < I_A) { transpose_item(a.in[19], 1024, DM, nullptr, Wb_t, 0, scr, r, lane); continue; } r -= I_A;
                if (r < I_O) { transpose_item(a.in[20], DM, DM, nullptr, Wo_t, 0, scr, r, lane); continue; } r -= I_O;
                if (r < I_O) { transpose_item(a.in[26], DM, DM, a.in[25], Wpg_t, 0, scr, r, lane); continue; } r -= I_O;
                if (r < I_PP) { transpose_item(a.in[27], 256, DM, nullptr, Wpp_t, 0, scr, r, lane); continue; } r -= I_PP;
                if (r < I_GU) { transpose_item(a.in[22], DM, FF, a.in[21], Wgu_t, 1, scr, r, lane); continue; } r -= I_GU;
                if (r < I_GU) { transpose_item(a.in[23], DM, FF, a.in[21], Wgu_t, 2, scr, r, lane); continue; } r -= I_GU;
                transpose_item(a.in[24], FF, DM, nullptr, Wd_t, 0, scr, r, lane);
            }
            for (int i = (bx - nb0) * 512 + tid; i < TOK * 256 / 8; i += (G - nb0) * 512) {
                const f32x4 p0 = __builtin_nontemporal_load((const f32x4*)(a.in[1] + (size_t)i * 8)), p1 = __builtin_nontemporal_load((const f32x4*)(a.in[1] + (size_t)i * 8 + 4));
                u32x4 w4; w4[0] = cvtpk(p0[0], p0[1]); w4[1] = cvtpk(p0[2], p0[3]); w4[2] = cvtpk(p1[0], p1[1]); w4[3] = cvtpk(p1[2], p1[3]);
                *(u32x4*)(PB + (size_t)i * 8) = w4;
            }
        }
        __syncthreads();
        float lam;
        { float s1 = 0.f, s2 = 0.f;
          for (int i = 0; i < 64; ++i) { s1 += a.in[10][i] * a.in[11][i]; s2 += a.in[12][i] * a.in[13][i]; }
          lam = expf(s1) - expf(s2) + 0.2f; }
        unsigned* queue = (unsigned*)(ctl + C_QUEUE);
        int qx = (int)(xb_xcc_id() & 7u), tries = 0;
        auto pop = [&]() -> unsigned {
            while (tries < 8) { const unsigned i = atomicAdd(queue + 16 * qx, 1u); if (i < 128u) return ((unsigned)qx << 7) | i; qx = (qx + 1) & 7; ++tries; }
            return 0xffffffffu; };
        if (tid == 0) lds_st<unsigned>(L + A_QSLOT, pop());
        __syncthreads();
        for (;;) {
            const unsigned u = lds_ld<unsigned>(L + A_QSLOT);
            if (u == 0xffffffffu) break;
            unsigned nxt = 0u;
            if (tid == 0) nxt = pop();
            attn_unit(L, (int)((u >> 7) + 8u * (u & 7u)), 15 - (int)((u >> 3) & 15u), PROJ, PROJ + PS, PROJ + 2 * PS, YA, a.in[8], a.in[9], a.in[15], a.in[14], lam);
            if (tid == 0) lds_st<unsigned>(L + A_QSLOT, nxt);
            __syncthreads();
        }
    }
    SEAM(4);
    if (IN(5)) {
        static_assert(WS_WB == WS_WA + (size_t)DM * 1024 * 2, "Wa_t and Wb_t are contiguous");
        pg8::Gemm g_{(const pg8::bf16_t*)YA, (const pg8::bf16_t*)Wa_t, 2 * TOK, 2 * DM, 1024}; MergeOrder S_; S_.init(G, bx);
        EpiMerge2 E{GAB, GAB + (size_t)TOK * 2048, MERGED};
        pg8::gemm_phase<EpiMerge2, MergeOrder, true, true>(LG, g_, S_, E);
    }
    SEAM(5);
    if (IN(6)) { EpiResid E{OUT, OUT, XB, ctl + C_SS3, 1.0f}; RUN_GEMM(EpiResid, MERGED, Wo_t, DM, DM, E); }
    SEAM(6);
    if (IN(7)) {
        { EpiSwiglu E{ACT, ctl + C_SS3}; RUN_GEMM(EpiSwiglu, XB, Wgu_t, 2 * FF, DM, E); }
        { int kple = 256; asm volatile("" : "+s"(kple)); EpiPle E{PLE, ctl + C_SSP}; RUN_GEMM(EpiPle, PB, Wpp_t, DM, kple, E); }
    }
    SEAM(7);
    if (IN(8)) { EpiResid E{OUT, OUT, XB, ctl + C_SS4, 0.5f}; RUN_GEMM(EpiResid, ACT, Wd_t, DM, FF, E); }
    SEAM(8);
    if (IN(9)) { EpiFinal E{OUT, PLE, ctl + C_SS4, ctl + C_SSP, a.in[28]}; RUN_GEMM(EpiFinal, XB, Wpg_t, DM, DM, E); }
#undef IN
#undef SEAM
#undef RUN_GEMM
}

#ifndef MK_PER_PHASE
#define MK_PER_PHASE 0
#endif
extern "C" void kernel_launch(void* const* d_in, const int* in_sizes, int n_in, void* d_out, int out_size, void* d_ws, size_t ws_size, hipStream_t stream) {
    static int grid = 0;
    if (grid == 0) {
        if (n_in != 29 || out_size != TOK * DM || ws_size < WS_END) { fprintf(stderr, "kernel_launch: unexpected problem: n_in %d out %d ws %zu (need >= %zu)\n", n_in, out_size, ws_size, (size_t)WS_END); grid = -1; return; }
        int dev = 0, cus = 0, per_cu = 0;
        (void)hipGetDevice(&dev); (void)hipDeviceGetAttribute(&cus, hipDeviceAttributeMultiprocessorCount, dev);
        if (hipFuncSetAttribute((const void*)fwd_megakernel, hipFuncAttributeMaxDynamicSharedMemorySize, LDS_BYTES) != hipSuccess) { fprintf(stderr, "kernel_launch: hipFuncSetAttribute failed\n"); grid = -1; return; }
        if (hipOccupancyMaxActiveBlocksPerMultiprocessor(&per_cu, (const void*)fwd_megakernel, 512, LDS_BYTES) != hipSuccess || per_cu < 1) { fprintf(stderr, "kernel_launch: occupancy query says %d\n", per_cu); per_cu = 1; }
        (void)hipGetLastError();
        grid = cus;
        if (grid <= 0) grid = 256;
    }
    if (grid < 0) return;
    if (hipMemsetAsync((char*)d_ws + WS_BAR, 0, 16384, stream) != hipSuccess) { fprintf(stderr, "kernel_launch: memset failed\n"); return; }
    Args a{};
    for (int i = 0; i < 29; ++i) a.in[i] = (const float*)d_in[i];
    a.out = (float*)d_out; a.ws = (unsigned char*)d_ws;
#if MK_PER_PHASE
    for (int p = 0; p < N_PHASES; ++p) { a.ph_lo = p; a.ph_hi = p + 1; hipLaunchKernelGGL(fwd_megakernel, dim3(grid), dim3(512), LDS_BYTES, stream, a); }
#else
    a.ph_lo = 0; a.ph_hi = N_PHASES;
    void* args[] = {&a};
    hipError_t e = hipLaunchCooperativeKernel((const void*)fwd_megakernel, dim3(grid), dim3(512), args, LDS_BYTES, stream);
    if (e != hipSuccess) fprintf(stderr, "kernel_launch: cooperative launch failed: %s (grid %d)\n", hipGetErrorString(e), grid);
#endif
}
```

```cpp
#include <hip/hip_runtime.h>
#include <hip/hip_cooperative_groups.h>
#include <cstdio>
#include <cstdint>
namespace cg = cooperative_groups;
namespace pg8 {
#define PG8_LAS __attribute__((address_space(3)))
typedef unsigned short bf16_t;
typedef short bf16x8 __attribute__((ext_vector_type(8)));
typedef float f32x4 __attribute__((ext_vector_type(4)));
typedef unsigned u32x4 __attribute__((ext_vector_type(4)));
constexpr int BM = 256, BK = 64, HALF = 128, HTB = HALF * BK * 2  , STAGE_BYTES = 8 * HTB, NXCD = 8, WGM = 8;

__host__ __device__ __forceinline__ int lds_byte(int r, int c) { const int st = (r >> 4) * 2 + (c >> 5), rr = r & 15, cc = c & 31, ob = rr * 64 + cc * 2; return st * 1024 + (ob ^ (((ob >> 9) & 1) << 5)); }
__host__ __device__ __forceinline__ void stage_rc(int b, int& R, int& C) { const int st = b / 1024, sb = b % 1024, swz = sb ^ (((sb >> 9) & 1) << 5); R = (st >> 1) * 16 + swz / 64; C = (st & 1) * 32 + (swz % 64) / 2; }
__host__ __device__ __forceinline__ int perm32(int rho) { const int n = rho >> 4, i = rho & 15; return 8 * (i >> 2) + 4 * n + (i & 3); }

struct Unit { int pm, pn; };
struct Gemm { const bf16_t* A; const bf16_t* Bt; int M, N, K; };

struct StaticOrder {
    int nM, nN, nwg, G, c;
    __host__ __device__ void init(int M, int N, int G_, int c_) { nM = M / BM; nN = N / BM; nwg = nM * nN; G = G_; c = c_; }
    __host__ __device__ bool next(int i, Unit& u) const {
        const long L = (long)i * G + c; if (L >= nwg) return false;
        int wgid = (int)L; { const int q = nwg / NXCD, r = nwg % NXCD, xcd = wgid % NXCD, off = wgid / NXCD; wgid = (xcd < r ? xcd * (q + 1) : r * (q + 1) + (xcd - r) * q) + off; }
        const int nig = WGM * nN, gid = wgid / nig, fm = gid * WGM, gsz = (nM - fm) < WGM ? (nM - fm) : WGM;
        u.pm = fm + ((wgid % nig) % gsz); u.pn = (wgid % nig) / gsz; return true;
    }
    __device__ __forceinline__ void a_ready(const Unit&) const {}
    __device__ __forceinline__ void done(const Unit&) const {}
};

__device__ __forceinline__ unsigned cvt_pk_bf16(float lo, float hi) { unsigned r; asm volatile("v_cvt_pk_bf16_f32 %0, %1, %2" : "=v"(r) : "v"(lo), "v"(hi)); return r; }
typedef float f32x2 __attribute__((ext_vector_type(2)));
template <class Epi, class Sched, bool ALIGN_EPI = false, bool SP2 = false>
__device__ __forceinline__ void gemm_phase(PG8_LAS unsigned char* lds, const Gemm g, const Sched& S, const Epi& E) {
    const int tid = threadIdx.x, wid = __builtin_amdgcn_readfirstlane(tid >> 6), lane = tid & 63, wr = wid >> 2, wc = wid & 3, fr = lane & 15, fq = lane >> 4;
    const int K = g.K, nt = K / BK;
    unsigned voffA[2], voffB[2];
#pragma unroll
    for (int i = 0; i < 2; ++i) { int R, C; stage_rc(tid * 16 + i * 8192, R, C); const int Rb = Epi::PERM ? ((R & ~31) + perm32(R & 31)) : R;
        voffA[i] = (unsigned)(R * K + C) * 2u; voffB[i] = (unsigned)(Rb * K + C) * 2u; }
    const size_t kstep = (size_t)(BK * 2);
    const size_t hstep = (size_t)HALF * K * 2;
    const size_t tstep = 2 * hstep;
    const unsigned ldsw = (unsigned)wid * 1024u;
    const int aoff = lds_byte(wr * 64 + fr, fq * 8), boff = lds_byte(wc * 32 + fr, fq * 8);
#define PG8_SA(b, h) (((b) * 2 + (h)) * HTB)
#define PG8_SB(b, h) ((4 + (b) * 2 + (h)) * HTB)
#define PG8_STAGE(bufoff, gbase, voff) do { _Pragma("unroll") for (int _i = 0; _i < 2; ++_i) \
        __builtin_amdgcn_global_load_lds((const unsigned*)((const char*)(gbase) + (voff)[_i]), (PG8_LAS unsigned*)(lds + (bufoff) + ldsw + _i * 8192), 16, 0, 0); } while (0)
#define PG8_LDA(dst, b, h) do { _Pragma("unroll") for (int m = 0; m < 4; ++m) _Pragma("unroll") for (int k = 0; k < 2; ++k) dst[m][k] = *(const PG8_LAS bf16x8*)(lds + PG8_SA(b, h) + aoff + m * 2048 + k * 1024); } while (0)
#define PG8_LDB(dst, b, h) do { _Pragma("unroll") for (int n = 0; n < 2; ++n) _Pragma("unroll") for (int k = 0; k < 2; ++k) dst[n][k] = *(const PG8_LAS bf16x8*)(lds + PG8_SB(b, h) + boff + n * 2048 + k * 1024); } while (0)
#define PG8_MMA(ai, bj, At, Bt) do { __builtin_amdgcn_s_setprio(1); _Pragma("unroll") for (int m = 0; m < 4; ++m) _Pragma("unroll") for (int n = 0; n < 2; ++n) _Pragma("unroll") for (int k = 0; k < 2; ++k) \
        acc[ai][bj][m][n] = __builtin_amdgcn_mfma_f32_16x16x32_bf16(Bt[n][k], At[m][k], acc[ai][bj][m][n], 0, 0, 0); __builtin_amdgcn_s_setprio(0); } while (0)
#define PG8_WAIT_V(n) asm volatile("s_waitcnt vmcnt(" #n ")" ::: "memory")
#define PG8_WAIT_L(n) asm volatile("s_waitcnt lgkmcnt(" #n ")" ::: "memory")
#define PG8_BAR __builtin_amdgcn_s_barrier()
#define PG8_SCHED __builtin_amdgcn_sched_barrier(0)
    Unit cur, nxt; int ui = 0;
    if (!S.next(0, cur)) return;
    f32x4 acc[2][2][4][2];
#pragma unroll
    for (int a = 0; a < 2; ++a)
#pragma unroll
        for (int b = 0; b < 2; ++b)
#pragma unroll
            for (int m = 0; m < 4; ++m)
#pragma unroll
                for (int n = 0; n < 2; ++n) acc[a][b][m][n] = (f32x4){0.f, 0.f, 0.f, 0.f};
    bf16x8 At[4][2], B0[2][2], B1[2][2];
    const char* cA = (const char*)g.A + (size_t)cur.pm * tstep; const char* cB = (const char*)g.Bt + (size_t)cur.pn * tstep;
    S.a_ready(cur);
    if constexpr (SP2) {
        PG8_STAGE(PG8_SB(0, 0), cB, voffB); PG8_STAGE(PG8_SB(0, 1), cB + hstep, voffB); PG8_STAGE(PG8_SA(0, 0), cA, voffA); PG8_STAGE(PG8_SA(0, 1), cA + hstep, voffA);
        if (wr == 1) PG8_BAR;
        PG8_WAIT_V(2); PG8_BAR;
        PG8_STAGE(PG8_SB(1, 0), cB + kstep, voffB); PG8_STAGE(PG8_SA(1, 0), cA + kstep, voffA); PG8_STAGE(PG8_SB(1, 1), cB + hstep + kstep, voffB);
        PG8_WAIT_V(6); PG8_BAR;
    } else {
        PG8_STAGE(PG8_SB(0, 0), cB, voffB); PG8_STAGE(PG8_SA(0, 0), cA, voffA); PG8_STAGE(PG8_SB(0, 1), cB + hstep, voffB); PG8_STAGE(PG8_SA(0, 1), cA + hstep, voffA);
        if (wr == 1) PG8_BAR;
        PG8_WAIT_V(4); PG8_BAR;
        PG8_STAGE(PG8_SB(1, 0), cB + kstep, voffB); PG8_STAGE(PG8_SA(1, 0), cA + kstep, voffA); PG8_STAGE(PG8_SB(1, 1), cB + hstep + kstep, voffB);
        PG8_WAIT_V(6); PG8_BAR;
    }
    for (;;) {
        const bool has_next = S.next(ui + 1, nxt);
        const char* nA = has_next ? (const char*)g.A + (size_t)nxt.pm * tstep : cA; const char* nB = has_next ? (const char*)g.Bt + (size_t)nxt.pn * tstep : cB;
        for (int t = 0; t < nt; t += 2) {
            const bool last = (t == nt - 2);
            const char* a1 = cA + (size_t)(t + 1) * kstep;
            const char* a2 = last ? nA : cA + (size_t)(t + 2) * kstep; const char* b2 = last ? nB : cB + (size_t)(t + 2) * kstep;
            const char* a3 = a2 + kstep; const char* b3 = b2 + kstep;
            if (last && has_next) S.a_ready(nxt);
            if constexpr (SP2) {
            PG8_LDB(B0, 0, 0); PG8_LDB(B1, 0, 1); PG8_SCHED; PG8_LDA(At, 0, 0); PG8_STAGE(PG8_SA(1, 1), a1 + hstep, voffA);
            PG8_WAIT_V(8); PG8_WAIT_L(0); PG8_BAR; PG8_MMA(0, 0, At, B0); PG8_MMA(0, 1, At, B1); PG8_BAR; PG8_SCHED;
            PG8_LDA(At, 0, 1); PG8_STAGE(PG8_SB(0, 0), b2, voffB); PG8_STAGE(PG8_SB(0, 1), b2 + hstep, voffB); PG8_STAGE(PG8_SA(0, 0), a2, voffA);
            PG8_WAIT_V(8); PG8_WAIT_L(0); PG8_BAR; PG8_MMA(1, 0, At, B0); PG8_MMA(1, 1, At, B1); PG8_BAR; PG8_SCHED;
            PG8_LDB(B0, 1, 0); PG8_LDB(B1, 1, 1); PG8_SCHED; PG8_LDA(At, 1, 0); PG8_STAGE(PG8_SA(0, 1), a2 + hstep, voffA);
            PG8_WAIT_V(8); PG8_WAIT_L(0); PG8_BAR; PG8_MMA(0, 0, At, B0); PG8_MMA(0, 1, At, B1); PG8_BAR; PG8_SCHED;
            PG8_LDA(At, 1, 1); PG8_STAGE(PG8_SB(1, 0), b3, voffB); PG8_STAGE(PG8_SB(1, 1), b3 + hstep, voffB); PG8_STAGE(PG8_SA(1, 0), a3, voffA);
            PG8_WAIT_V(8); PG8_WAIT_L(0); PG8_BAR; PG8_MMA(1, 0, At, B0); PG8_MMA(1, 1, At, B1); PG8_BAR; PG8_SCHED;
            } else {
            PG8_LDB(B0, 0, 0); PG8_SCHED; PG8_LDA(At, 0, 0); PG8_STAGE(PG8_SA(1, 1), a1 + hstep, voffA);
            PG8_WAIT_L(8); PG8_BAR; PG8_WAIT_L(0); PG8_MMA(0, 0, At, B0); PG8_BAR; PG8_SCHED;
            PG8_LDB(B1, 0, 1); PG8_STAGE(PG8_SB(0, 0), b2, voffB);
            PG8_BAR; PG8_WAIT_L(0); PG8_MMA(0, 1, At, B1); PG8_BAR;
            PG8_LDA(At, 0, 1); PG8_STAGE(PG8_SA(0, 0), a2, voffA);
            PG8_BAR; PG8_WAIT_L(0); PG8_MMA(1, 0, At, B0); PG8_BAR; PG8_SCHED;
            PG8_STAGE(PG8_SB(0, 1), b2 + hstep, voffB);
            PG8_WAIT_V(6); PG8_BAR; PG8_MMA(1, 1, At, B1); PG8_BAR;
            PG8_LDB(B0, 1, 0); PG8_SCHED; PG8_LDA(At, 1, 0); PG8_STAGE(PG8_SA(0, 1), a2 + hstep, voffA);
            PG8_WAIT_L(8); PG8_BAR; PG8_WAIT_L(0); PG8_MMA(0, 0, At, B0); PG8_BAR; PG8_SCHED;
            PG8_LDB(B1, 1, 1); PG8_STAGE(PG8_SB(1, 0), b3, voffB);
            PG8_BAR; PG8_WAIT_L(0); PG8_MMA(0, 1, At, B1); PG8_BAR;
            PG8_LDA(At, 1, 1); PG8_STAGE(PG8_SA(1, 0), a3, voffA);
            PG8_BAR; PG8_WAIT_L(0); PG8_MMA(1, 0, At, B0); PG8_BAR; PG8_SCHED;
            PG8_STAGE(PG8_SB(1, 1), b3 + hstep, voffB);
            PG8_WAIT_V(6); PG8_BAR; PG8_MMA(1, 1, At, B1); PG8_BAR;
            }
        }
        if constexpr (ALIGN_EPI) { if (wr == 0) PG8_BAR; }
        if constexpr (!Epi::AFTER_DRAIN) { E(acc, cur, wr, wc, fr, fq); S.done(cur); }
        if (!has_next) break;
#pragma unroll
        for (int a = 0; a < 2; ++a)
#pragma unroll
            for (int b = 0; b < 2; ++b)
#pragma unroll
                for (int m = 0; m < 4; ++m)
#pragma unroll
                    for (int n = 0; n < 2; ++n) acc[a][b][m][n] = (f32x4){0.f, 0.f, 0.f, 0.f};
        cur = nxt; cA = nA; cB = nB; ++ui;
        if constexpr (ALIGN_EPI) { if (wr == 1) PG8_BAR; }
    }
    PG8_WAIT_V(0);
    if constexpr (!ALIGN_EPI) { if (wr == 0) PG8_BAR; }
    PG8_BAR;
    if constexpr (Epi::AFTER_DRAIN) { E.fused(acc, cur, wr, wc, fr, fq, lds, wid, lane); S.done(cur); }
#undef PG8_SA
#undef PG8_SB
#undef PG8_STAGE
#undef PG8_LDA
#undef PG8_LDB
#undef PG8_MMA
#undef PG8_WAIT_V
#undef PG8_WAIT_L
#undef PG8_BAR
#undef PG8_SCHED
}
}

constexpr int TOK = 16384, DM = 2048, FF = 5632, NIN = 11264, SEQ = 2048;
constexpr float EPS = 1e-6f, LOG2E = 1.4426950408889634f;
constexpr size_t MiB = (size_t)1 << 20;
constexpr size_t WS_CTL = 0;
constexpr size_t WS_WIN = 1 * MiB;
constexpr size_t WS_WA = 1 * MiB, WS_WB = 5 * MiB, WS_WO = 9 * MiB, WS_WPG = 17 * MiB, WS_WPP = 25 * MiB, WS_PB = 26 * MiB;
constexpr size_t WS_WGU = 45 * MiB;
constexpr size_t WS_WD = 89 * MiB;
constexpr size_t WS_XB = 111 * MiB;
constexpr size_t WS_BIG = 175 * MiB;
constexpr size_t WS_END = 527 * MiB;
constexpr size_t BIG_GA = 224 * MiB, BIG_PLE = 176 * MiB;
constexpr int C_SS1 = 0, C_SS2 = 16384, C_SS3 = 32768, C_SS4 = 49152, C_SSP = 65536, C_QUEUE = 81920, C_ZERO_END = 82048;

typedef unsigned short bf16;
#define LAS __attribute__((address_space(3)))
typedef LAS unsigned char* ldsp;
typedef float f32x4 __attribute__((ext_vector_type(4)));
typedef float f32x16 __attribute__((ext_vector_type(16)));
typedef unsigned u32x4 __attribute__((ext_vector_type(4)));
typedef unsigned u32x2 __attribute__((ext_vector_type(2)));
typedef short bf16x8 __attribute__((ext_vector_type(8)));
typedef short s16x4 __attribute__((ext_vector_type(4)));
typedef float f32x2_t __attribute__((ext_vector_type(2)));
typedef __bf16 bf16x2_t __attribute__((ext_vector_type(2)));

template <class T> __device__ __forceinline__ T lds_ld(ldsp p) { return *(const LAS T*)p; }
template <class T> __device__ __forceinline__ void lds_st(ldsp p, T v) { *(LAS T*)p = v; }
__device__ __forceinline__ unsigned cvtpk(float lo, float hi) { f32x2_t v = {lo, hi}; bf16x2_t b = __builtin_convertvector(v, bf16x2_t); return __builtin_bit_cast(unsigned, b); }
__device__ __forceinline__ float bflo(unsigned w) { return __uint_as_float(w << 16); }
__device__ __forceinline__ float bfhi(unsigned w) { return __uint_as_float(w & 0xffff0000u); }
__device__ __forceinline__ float sigm(float x) { return __builtin_amdgcn_rcpf(1.f + __builtin_amdgcn_exp2f(-x * LOG2E)); }
__device__ __forceinline__ int crow(int r, int hi) { return (r & 3) + 8 * (r >> 2) + 4 * hi; }
__device__ __forceinline__ s16x4 tr_ld(ldsp p) { typedef short v4i16_t __attribute__((ext_vector_type(4))); return __builtin_bit_cast(s16x4, __builtin_amdgcn_ds_read_tr16_b64_v4i16((LAS v4i16_t*)p)); }
__device__ __forceinline__ bf16x8 cat4(s16x4 a, s16x4 b) { return (bf16x8){a[0], a[1], a[2], a[3], b[0], b[1], b[2], b[3]}; }
__device__ __forceinline__ bf16x8 pack8(const f32x16& x, int s) { u32x4 p; p[0] = cvtpk(x[8 * s], x[8 * s + 1]); p[1] = cvtpk(x[8 * s + 2], x[8 * s + 3]); p[2] = cvtpk(x[8 * s + 4], x[8 * s + 5]); p[3] = cvtpk(x[8 * s + 6], x[8 * s + 7]); return __builtin_bit_cast(bf16x8, p); }
#define DPP_F(v, ctrl) __builtin_bit_cast(float, __builtin_amdgcn_update_dpp(0, __builtin_bit_cast(int, (v)), (ctrl), 0xf, 0xf, true))
#define MFMA32(a, b, c) __builtin_amdgcn_mfma_f32_32x32x16_bf16((a), (b), (c), 0, 0, 0)

struct EpiSwiglu {
    static constexpr bool PERM = true, AFTER_DRAIN = false;
    bf16* O; const float* ss;
    __device__ __forceinline__ void operator()(const pg8::f32x4 (&acc)[2][2][4][2], const pg8::Unit& u, int wr, int wc, int fr, int fq) const {
        const int col0 = u.pn * 128 + wc * 32 + 8 * fq, row0 = u.pm * 256 + wr * 64 + fr;
        float rsv[2][4];
#pragma unroll
        for (int ai = 0; ai < 2; ++ai)
#pragma unroll
            for (int m = 0; m < 4; ++m) rsv[ai][m] = ss[row0 + ai * 128 + m * 16];
#pragma unroll
        for (int ai = 0; ai < 2; ++ai)
#pragma unroll
            for (int m = 0; m < 4; ++m) {
                const int row = row0 + ai * 128 + m * 16;
                const float rs = rsqrtf(rsv[ai][m] * (1.f / DM) + EPS), c1 = -rs * LOG2E, rs2 = rs * rs;
                u32x4 w;
#pragma unroll
                for (int n = 0; n < 2; ++n) {
                    const pg8::f32x4 g = acc[ai][0][m][n], up = acc[ai][1][m][n];
                    float o4[4];
#pragma unroll
                    for (int k = 0; k < 4; ++k) o4[k] = (g[k] * up[k]) * (rs2 * __builtin_amdgcn_rcpf(1.f + __builtin_amdgcn_exp2f(g[k] * c1)));
                    w[2 * n] = cvtpk(o4[0], o4[1]); w[2 * n + 1] = cvtpk(o4[2], o4[3]);
                }
                *(u32x4*)(O + (size_t)row * FF + col0) = w;
            }
    }
};
struct EpiResid {
    static constexpr bool PERM = true, AFTER_DRAIN = false;
    const float* R; float* X; bf16* XB; float* ssout; float alpha;
    __device__ __forceinline__ void operator()(const pg8::f32x4 (&acc)[2][2][4][2], const pg8::Unit& u, int wr, int wc, int fr, int fq) const {
        const int row0 = u.pm * 256 + wr * 64 + fr, colb = u.pn * 256 + wc * 32 + 8 * fq;
#pragma unroll
        for (int ai = 0; ai < 2; ++ai) {
            pg8::f32x4 rv[4][2][2];
#pragma unroll
            for (int m = 0; m < 4; ++m)
#pragma unroll
                for (int bj = 0; bj < 2; ++bj) { const size_t off = (size_t)(row0 + ai * 128 + m * 16) * DM + colb + bj * 128;
                    rv[m][bj][0] = *(const pg8::f32x4*)(R + off); rv[m][bj][1] = *(const pg8::f32x4*)(R + off + 4); }
#pragma unroll
            for (int m = 0; m < 4; ++m) {
                const int row = row0 + ai * 128 + m * 16;
                float sq = 0.f;
#pragma unroll
                for (int bj = 0; bj < 2; ++bj) {
                    const size_t off = (size_t)row * DM + colb + bj * 128;
                    const pg8::f32x4 v0 = rv[m][bj][0] + acc[ai][bj][m][0] * alpha, v1 = rv[m][bj][1] + acc[ai][bj][m][1] * alpha;
                    *(pg8::f32x4*)(X + off) = v0; *(pg8::f32x4*)(X + off + 4) = v1;
                    u32x4 w; w[0] = cvtpk(v0[0], v0[1]); w[1] = cvtpk(v0[2], v0[3]); w[2] = cvtpk(v1[0], v1[1]); w[3] = cvtpk(v1[2], v1[3]);
                    *(u32x4*)(XB + off) = w;
                    sq += (v0[0] * v0[0] + v0[1] * v0[1]) + (v0[2] * v0[2] + v0[3] * v0[3]) + (v1[0] * v1[0] + v1[1] * v1[1]) + (v1[2] * v1[2] + v1[3] * v1[3]);
                }
                sq += __shfl_xor(sq, 16); sq += __shfl_xor(sq, 32);
                if (fq == 0) atomicAdd(ssout + row, sq);
            }
        }
    }
};
struct EpiProj {
    static constexpr bool PERM = true, AFTER_DRAIN = false;
    bf16* P; bf16* GA; const float* ss;
    __device__ __forceinline__ void operator()(const pg8::f32x4 (&acc)[2][2][4][2], const pg8::Unit& u, int wr, int wc, int fr, int fq) const {
        if (u.pn < 8) {
            bf16* qb_ = P + (size_t)(u.pn >> 2) * TOK * 1024 + (u.pn & 3) * 256 + 64 * wc + 8 * fq;
            const int rowq = u.pm * 256 + wr * 64 + fr;
            float rsq_[2][4];
#pragma unroll
            for (int ai = 0; ai < 2; ++ai)
#pragma unroll
                for (int m = 0; m < 4; ++m) rsq_[ai][m] = ss[rowq + ai * 128 + m * 16];
#pragma unroll
            for (int ai = 0; ai < 2; ++ai)
#pragma unroll
                for (int m = 0; m < 4; ++m) {
                    const int row = rowq + ai * 128 + m * 16;
                    const float rs = rsqrtf(rsq_[ai][m] * (1.f / DM) + EPS);
                    const pg8::f32x4 a0 = acc[ai][0][m][0] * rs, a1 = acc[ai][0][m][1] * rs, b0 = acc[ai][1][m][0] * rs, b1 = acc[ai][1][m][1] * rs;
                    float sq = (a0[0] * a0[0] + a0[1] * a0[1]) + (a0[2] * a0[2] + a0[3] * a0[3]) + (a1[0] * a1[0] + a1[1] * a1[1]) + (a1[2] * a1[2] + a1[3] * a1[3])
                             + (b0[0] * b0[0] + b0[1] * b0[1]) + (b0[2] * b0[2] + b0[3] * b0[3]) + (b1[0] * b1[0] + b1[1] * b1[1]) + (b1[2] * b1[2] + b1[3] * b1[3]);
                    sq += __shfl_xor(sq, 16); sq += __shfl_xor(sq, 32);
                    const float rn = rsqrtf(sq * (1.f / 64.f) + EPS);
                    u32x4 w0, w1;
                    w0[0] = cvtpk(a0[0] * rn, a0[1] * rn); w0[1] = cvtpk(a0[2] * rn, a0[3] * rn); w0[2] = cvtpk(a1[0] * rn, a1[1] * rn); w0[3] = cvtpk(a1[2] * rn, a1[3] * rn);
                    w1[0] = cvtpk(b0[0] * rn, b0[1] * rn); w1[1] = cvtpk(b0[2] * rn, b0[3] * rn); w1[2] = cvtpk(b1[0] * rn, b1[1] * rn); w1[3] = cvtpk(b1[2] * rn, b1[3] * rn);
                    *(u32x4*)(qb_ + (size_t)row * 1024) = w0; *(u32x4*)(qb_ + (size_t)row * 1024 + 32) = w1;
                }
            return;
        }
        const bool gate = u.pn >= 28;
        bf16* base; int ld, colt;
        if (!gate) { base = P + (size_t)(u.pn >> 2) * TOK * 1024; ld = 1024; colt = (u.pn & 3) * 256; }
        else { const int g = u.pn - 28; base = GA + (size_t)(g >> 3) * TOK * 2048; ld = 2048; colt = (g & 7) * 256; }
        colt += wc * 32 + 8 * fq;
        const int grp = u.pn >> 2;
        const int actm = (gate || grp == 4) ? 1 : ((grp == 3 || grp == 6) ? 2 : 0);
        const int row0 = u.pm * 256 + wr * 64 + fr;
        float rsv[2][4];
#pragma unroll
        for (int ai = 0; ai < 2; ++ai)
#pragma unroll
            for (int m = 0; m < 4; ++m) rsv[ai][m] = ss[row0 + ai * 128 + m * 16];
#pragma unroll
        for (int ai = 0; ai < 2; ++ai)
#pragma unroll
            for (int m = 0; m < 4; ++m) {
                const int row = row0 + ai * 128 + m * 16;
                const float rs = rsqrtf(rsv[ai][m] * (1.f / DM) + EPS);
#pragma unroll
                for (int bj = 0; bj < 2; ++bj) {
                    pg8::f32x4 v0 = acc[ai][bj][m][0], v1 = acc[ai][bj][m][1];
                    if (actm == 0) { v0 = v0 * rs; v1 = v1 * rs; }
                    else {
                        const float c1 = -rs * LOG2E, sc = (actm == 2) ? rs : 0.f;
#pragma unroll
                        for (int i = 0; i < 4; ++i) {
                            const float s0 = __builtin_amdgcn_rcpf(1.f + __builtin_amdgcn_exp2f(v0[i] * c1)), s1 = __builtin_amdgcn_rcpf(1.f + __builtin_amdgcn_exp2f(v1[i] * c1));
                            v0[i] = (actm == 2) ? v0[i] * sc * s0 : s0; v1[i] = (actm == 2) ? v1[i] * sc * s1 : s1; }
                    }
                    u32x4 w; w[0] = cvtpk(v0[0], v0[1]); w[1] = cvtpk(v0[2], v0[3]); w[2] = cvtpk(v1[0], v1[1]); w[3] = cvtpk(v1[2], v1[3]);
                    *(u32x4*)(base + (size_t)row * ld + colt + bj * 128) = w;
                }
            }
    }
};
template <bool FIRST> struct EpiMerge {
    static constexpr bool PERM = true, AFTER_DRAIN = false;
    const bf16* G; bf16* Mg;
    __device__ __forceinline__ void operator()(const pg8::f32x4 (&acc)[2][2][4][2], const pg8::Unit& u, int wr, int wc, int fr, int fq) const {
        const int row0 = u.pm * 256 + wr * 64 + fr, colb = u.pn * 256 + wc * 32 + 8 * fq;
#pragma unroll
        for (int ai = 0; ai < 2; ++ai) {
            u32x4 gv[4][2], pv[4][2];
#pragma unroll
            for (int m = 0; m < 4; ++m)
#pragma unroll
                for (int bj = 0; bj < 2; ++bj) { const size_t off = (size_t)(row0 + ai * 128 + m * 16) * DM + colb + bj * 128;
                    gv[m][bj] = *(const u32x4*)(G + off); if (!FIRST) pv[m][bj] = *(const u32x4*)(Mg + off); else pv[m][bj] = (u32x4){0u, 0u, 0u, 0u}; }
#pragma unroll
            for (int m = 0; m < 4; ++m)
#pragma unroll
                for (int bj = 0; bj < 2; ++bj) {
                    const size_t off = (size_t)(row0 + ai * 128 + m * 16) * DM + colb + bj * 128;
                    const u32x4 gw = gv[m][bj];
                    pg8::f32x4 v0 = acc[ai][bj][m][0], v1 = acc[ai][bj][m][1];
                    v0[0] *= bflo(gw[0]); v0[1] *= bfhi(gw[0]); v0[2] *= bflo(gw[1]); v0[3] *= bfhi(gw[1]);
                    v1[0] *= bflo(gw[2]); v1[1] *= bfhi(gw[2]); v1[2] *= bflo(gw[3]); v1[3] *= bfhi(gw[3]);
                    if (!FIRST) { const u32x4 pw = pv[m][bj];
                        v0[0] += bflo(pw[0]); v0[1] += bfhi(pw[0]); v0[2] += bflo(pw[1]); v0[3] += bfhi(pw[1]);
                        v1[0] += bflo(pw[2]); v1[1] += bfhi(pw[2]); v1[2] += bflo(pw[3]); v1[3] += bfhi(pw[3]); }
                    u32x4 w; w[0] = cvtpk(v0[0], v0[1]); w[1] = cvtpk(v0[2], v0[3]); w[2] = cvtpk(v1[0], v1[1]); w[3] = cvtpk(v1[2], v1[3]);
                    *(u32x4*)(Mg + off) = w;
                }
        }
    }
};
struct MergeOrder {
    pg8::StaticOrder so; int nt;
    __device__ __forceinline__ void init(int G_, int c_) { so.init(TOK, DM, G_, c_); nt = (so.nwg > c_) ? (so.nwg - c_ + G_ - 1) / G_ : 0; }
    __device__ __forceinline__ bool next(int i, pg8::Unit& u) const {
        if (i >= 2 * nt) return false;
        const bool second = i >= nt;
        if (!so.next(second ? i - nt : i, u)) return false;
        if (second) { u.pm += TOK / 256; u.pn += DM / 256; }
        return true;
    }
    __device__ __forceinline__ void a_ready(const pg8::Unit&) const {}
    __device__ __forceinline__ void done(const pg8::Unit&) const {}
};
struct EpiMerge2 {
    static constexpr bool PERM = true, AFTER_DRAIN = false;
    const bf16* GA_; const bf16* GB_; bf16* Mg;
    __device__ __forceinline__ void operator()(const pg8::f32x4 (&acc)[2][2][4][2], const pg8::Unit& u, int wr, int wc, int fr, int fq) const {
        const bool second = u.pm >= TOK / 256;
        const int pm = second ? u.pm - TOK / 256 : u.pm, pn = second ? u.pn - DM / 256 : u.pn;
        const bf16* G = second ? GB_ : GA_;
        const int row0 = pm * 256 + wr * 64 + fr, colb = pn * 256 + wc * 32 + 8 * fq;
#pragma unroll
        for (int ai = 0; ai < 2; ++ai) {
            u32x4 gv[4][2], pv[4][2];
#pragma unroll
            for (int m = 0; m < 4; ++m)
#pragma unroll
                for (int bj = 0; bj < 2; ++bj) { const size_t off = (size_t)(row0 + ai * 128 + m * 16) * DM + colb + bj * 128;
                    gv[m][bj] = *(const u32x4*)(G + off); pv[m][bj] = (u32x4){0u, 0u, 0u, 0u}; if (second) pv[m][bj] = *(const u32x4*)(Mg + off); }
#pragma unroll
            for (int m = 0; m < 4; ++m)
#pragma unroll
                for (int bj = 0; bj < 2; ++bj) {
                    const size_t off = (size_t)(row0 + ai * 128 + m * 16) * DM + colb + bj * 128;
                    const u32x4 gw = gv[m][bj], pw = pv[m][bj];
                    pg8::f32x4 v0 = acc[ai][bj][m][0], v1 = acc[ai][bj][m][1];
                    v0[0] = v0[0] * bflo(gw[0]) + bflo(pw[0]); v0[1] = v0[1] * bfhi(gw[0]) + bfhi(pw[0]); v0[2] = v0[2] * bflo(gw[1]) + bflo(pw[1]); v0[3] = v0[3] * bfhi(gw[1]) + bfhi(pw[1]);
                    v1[0] = v1[0] * bflo(gw[2]) + bflo(pw[2]); v1[1] = v1[1] * bfhi(gw[2]) + bfhi(pw[2]); v1[2] = v1[2] * bflo(gw[3]) + bflo(pw[3]); v1[3] = v1[3] * bfhi(gw[3]) + bfhi(pw[3]);
                    u32x4 w; w[0] = cvtpk(v0[0], v0[1]); w[1] = cvtpk(v0[2], v0[3]); w[2] = cvtpk(v1[0], v1[1]); w[3] = cvtpk(v1[2], v1[3]);
                    *(u32x4*)(Mg + off) = w;
                }
        }
    }
};
struct EpiPle {
    static constexpr bool PERM = true, AFTER_DRAIN = false;
    bf16* O; float* ssout;
    __device__ __forceinline__ void operator()(const pg8::f32x4 (&acc)[2][2][4][2], const pg8::Unit& u, int wr, int wc, int fr, int fq) const {
#pragma unroll
        for (int ai = 0; ai < 2; ++ai)
#pragma unroll
            for (int m = 0; m < 4; ++m) {
                const int row = u.pm * 256 + ai * 128 + wr * 64 + m * 16 + fr;
                float sq = 0.f;
#pragma unroll
                for (int bj = 0; bj < 2; ++bj) {
                    const size_t off = (size_t)row * DM + u.pn * 256 + bj * 128 + wc * 32 + 8 * fq;
                    const pg8::f32x4 v0 = acc[ai][bj][m][0], v1 = acc[ai][bj][m][1];
                    u32x4 w; w[0] = cvtpk(v0[0], v0[1]); w[1] = cvtpk(v0[2], v0[3]); w[2] = cvtpk(v1[0], v1[1]); w[3] = cvtpk(v1[2], v1[3]);
                    *(u32x4*)(O + off) = w;
                    sq += (v0[0] * v0[0] + v0[1] * v0[1]) + (v0[2] * v0[2] + v0[3] * v0[3]) + (v1[0] * v1[0] + v1[1] * v1[1]) + (v1[2] * v1[2] + v1[3] * v1[3]);
                }
                sq += __shfl_xor(sq, 16); sq += __shfl_xor(sq, 32);
                if (fq == 0) atomicAdd(ssout + row, sq);
            }
    }
};
struct EpiFinal {
    static constexpr bool PERM = true, AFTER_DRAIN = false;
    float* X; const bf16* PLE; const float* ss4; const float* ssp; const float* gpost;
    __device__ __forceinline__ void operator()(const pg8::f32x4 (&acc)[2][2][4][2], const pg8::Unit& u, int wr, int wc, int fr, int fq) const {
        const int row0 = u.pm * 256 + wr * 64 + fr, colb = u.pn * 256 + wc * 32 + 8 * fq;
        float s4[2][4], sp[2][4]; pg8::f32x4 gp[2][2];
#pragma unroll
        for (int ai = 0; ai < 2; ++ai)
#pragma unroll
            for (int m = 0; m < 4; ++m) { s4[ai][m] = ss4[row0 + ai * 128 + m * 16]; sp[ai][m] = ssp[row0 + ai * 128 + m * 16]; }
#pragma unroll
        for (int bj = 0; bj < 2; ++bj) { gp[bj][0] = *(const pg8::f32x4*)(gpost + colb + bj * 128); gp[bj][1] = *(const pg8::f32x4*)(gpost + colb + bj * 128 + 4); }
#pragma unroll
        for (int ai = 0; ai < 2; ++ai)
#pragma unroll
            for (int mp = 0; mp < 2; ++mp) {
                pg8::f32x4 xv[2][2][2]; u32x4 pl[2][2];
#pragma unroll
                for (int mm = 0; mm < 2; ++mm)
#pragma unroll
                    for (int bj = 0; bj < 2; ++bj) { const size_t off = (size_t)(row0 + ai * 128 + (2 * mp + mm) * 16) * DM + colb + bj * 128;
                        xv[mm][bj][0] = *(const pg8::f32x4*)(X + off); xv[mm][bj][1] = *(const pg8::f32x4*)(X + off + 4); pl[mm][bj] = *(const u32x4*)(PLE + off); }
#pragma unroll
                for (int mm = 0; mm < 2; ++mm) {
                    const int m = 2 * mp + mm;
                    const float rs = rsqrtf(s4[ai][m] * (1.f / DM) + EPS), rp = rsqrtf(sp[ai][m] * (1.f / DM) + EPS);
#pragma unroll
                    for (int bj = 0; bj < 2; ++bj) {
                        const size_t off = (size_t)(row0 + ai * 128 + m * 16) * DM + colb + bj * 128;
                        const u32x4 pw = pl[mm][bj];
                        const pg8::f32x4 g0 = gp[bj][0], g1 = gp[bj][1];
                        pg8::f32x4 x0 = xv[mm][bj][0], x1 = xv[mm][bj][1];
                        const pg8::f32x4 a0 = acc[ai][bj][m][0] * rs, a1 = acc[ai][bj][m][1] * rs;
                        x0[0] += sigm(a0[0]) * (bflo(pw[0]) * rp * g0[0]); x0[1] += sigm(a0[1]) * (bfhi(pw[0]) * rp * g0[1]);
                        x0[2] += sigm(a0[2]) * (bflo(pw[1]) * rp * g0[2]); x0[3] += sigm(a0[3]) * (bfhi(pw[1]) * rp * g0[3]);
                        x1[0] += sigm(a1[0]) * (bflo(pw[2]) * rp * g1[0]); x1[1] += sigm(a1[1]) * (bfhi(pw[2]) * rp * g1[1]);
                        x1[2] += sigm(a1[2]) * (bflo(pw[3]) * rp * g1[2]); x1[3] += sigm(a1[3]) * (bfhi(pw[3]) * rp * g1[3]);
                        *(pg8::f32x4*)(X + off) = x0; *(pg8::f32x4*)(X + off + 4) = x1;
                    }
                }
            }
    }
};

__device__ __forceinline__ float wave_sum(float v) {
#pragma unroll
    for (int o = 1; o < 64; o <<= 1) v += __shfl_xor(v, o);
    return v;
}
__device__ __forceinline__ void transpose_item(const float* __restrict__ W, int K, int N, const float* __restrict__ gain, bf16* WT, int mode, ldsp scr, int item, int lane) {
    const int nblk = N / 32, kb = item / nblk, nb = item % nblk, k0 = 64 * kb, n0 = 32 * nb;
    int r0;
    if (mode == 0) r0 = n0;
    else if (mode == 3) r0 = (n0 < 2048) ? ((n0 & ~255) + ((n0 >> 5) & 1) * 128 + ((n0 >> 6) & 3) * 32) : n0;
    else r0 = (n0 >> 7) * 256 + (mode == 2 ? 128 : 0) + (n0 & 127);
    float tv[32];
#pragma unroll
    for (int i = 0; i < 32; ++i) tv[i] = __builtin_nontemporal_load(&W[(size_t)(k0 + 2 * i + (lane >> 5)) * N + n0 + (lane & 31)]);
#pragma unroll
    for (int i = 0; i < 32; ++i) { const int kk = 2 * i + (lane >> 5); float v = tv[i]; if (gain) v *= gain[k0 + kk]; lds_st<float>(scr + 4 * (kk * 33 + (lane & 31)), v); }
    asm volatile("s_waitcnt lgkmcnt(0)" ::: "memory");
    const int c = lane & 7;
#pragma unroll
    for (int j = 0; j < 4; ++j) { const int n = (lane >> 3) + 8 * j; ldsp s = scr + 4 * ((8 * c) * 33 + n);
        u32x4 o; o[0] = cvtpk(lds_ld<float>(s), lds_ld<float>(s + 132)); o[1] = cvtpk(lds_ld<float>(s + 264), lds_ld<float>(s + 396));
        o[2] = cvtpk(lds_ld<float>(s + 528), lds_ld<float>(s + 660)); o[3] = cvtpk(lds_ld<float>(s + 792), lds_ld<float>(s + 924));
        *(u32x4*)(WT + (size_t)(r0 + n) * K + k0 + 8 * c) = o; }
    asm volatile("s_waitcnt lgkmcnt(0)" ::: "memory");
}
#define RLX_AGENT __ATOMIC_RELAXED, __HIP_MEMORY_SCOPE_AGENT
#define XB_TMO      128
#define XB_XCNT(j)  (256  + 64 * (j))
#define XB_XSUB(j)  (1280 + 64 * (j))
#define XB_XGEN(j)  (2304 + 64 * (j))
#define XB_TOP      3328
#define XB_TOPGEN   3392
#define XCD_BAR_WORDS 3456
#define XB_SPIN_CAP (1u << 18)

__device__ __forceinline__ unsigned xb_ld(unsigned* p)              { return __hip_atomic_load(p, __ATOMIC_RELAXED, __HIP_MEMORY_SCOPE_AGENT); }
__device__ __forceinline__ unsigned xb_add(unsigned* p, unsigned v) { return __hip_atomic_fetch_add(p, v, __ATOMIC_RELAXED, __HIP_MEMORY_SCOPE_AGENT); }
__device__ __forceinline__ unsigned xb_xcc_id() { return (unsigned)__builtin_amdgcn_s_getreg((3 << 11) | 20) & 0xFu; }
#define XB_SPIN(cond, bar) do { unsigned _sp = 0; while (cond) { __builtin_amdgcn_s_sleep(1); \
    if ((++_sp & 255u) == 0u) { if (xb_ld(&(bar)[XB_TMO])) break; if (_sp > XB_SPIN_CAP) { atomicAdd(&(bar)[XB_TMO], 1u); break; } } } } while (0)

struct XcdBarrier {
    unsigned* bar; unsigned x;
    volatile LAS unsigned* st;
};

__device__ __forceinline__ XcdBarrier xcd_barrier_post(unsigned* bar, volatile LAS unsigned* st) {
    XcdBarrier b; b.bar = bar; b.x = xb_xcc_id(); b.st = st;
    if (threadIdx.x == 0) (void)xb_add(&bar[XB_XCNT(b.x)], 1u);
    return b;
}
__device__ __forceinline__ void xcd_barrier_complete(unsigned* bar, unsigned x, unsigned& nloc, unsigned& nx) {
    const unsigned G = gridDim.x * gridDim.y * gridDim.z;
    unsigned sum, cnt, mine, sp = 0u;
    for (;;) {
        sum = 0u; cnt = 0u; mine = 0u;
#pragma unroll
        for (unsigned j = 0; j < 16; ++j) { const unsigned c = xb_ld(&bar[XB_XCNT(j)]); sum += c; cnt += (c > 0u) ? 1u : 0u; mine = (j == x) ? c : mine; }
        if (sum == G) break;
        __builtin_amdgcn_s_sleep(1);
        if ((++sp & 255u) == 0u) { if (xb_ld(&bar[XB_TMO])) break; if (sp > XB_SPIN_CAP) { atomicAdd(&bar[XB_TMO], 1u); break; } }
    }
    nloc = mine > 0u ? mine : 1u; nx = cnt > 0u ? cnt : 1u;
}

__device__ __forceinline__ void xcd_barrier(const XcdBarrier& b) {
    asm volatile("s_waitcnt vmcnt(0)" ::: "memory");
    __syncthreads();
    if (threadIdx.x == 0) {
        unsigned* bar = b.bar;
        __builtin_amdgcn_s_waitcnt(0);
        unsigned nloc = b.st[0], nx = b.st[1];
        if (nloc == 0u) { xcd_barrier_complete(bar, b.x, nloc, nx); b.st[0] = nloc; b.st[1] = nx; }
        const unsigned old = xb_add(&bar[XB_XSUB(b.x)], 1u);
        const unsigned gen = old / nloc;
        if (old + 1u == (gen + 1u) * nloc) {
            __builtin_amdgcn_fence(__ATOMIC_RELEASE, "agent");
            asm volatile("s_waitcnt vmcnt(0)" ::: "memory");
            const unsigned og = xb_add(&bar[XB_TOP], 1u);
            const unsigned tg = og / nx;
            if (og + 1u == (tg + 1u) * nx) xb_add(&bar[XB_TOPGEN], 1u);
            else XB_SPIN(xb_ld(&bar[XB_TOPGEN]) == tg, bar);
            __builtin_amdgcn_fence(__ATOMIC_ACQUIRE, "agent");
            xb_add(&bar[XB_XGEN(b.x)], 1u);
            asm volatile("s_waitcnt vmcnt(0)" ::: "memory");
        } else {
            XB_SPIN(xb_ld(&bar[XB_XGEN(b.x)]) == gen, bar);
            __builtin_amdgcn_fence(__ATOMIC_ACQUIRE, "agent");
            asm volatile("s_waitcnt vmcnt(0)" ::: "memory");
        }
    }
    __syncthreads();
}

constexpr int A_KP = 144, A_KT = 64 * A_KP, A_VP = 320, A_VT = 64 * A_VP, A_STAGE = 2 * A_KT + A_VT;
constexpr int A_TAB = 131072, A_WSF = A_TAB + 512, A_QSLOT = A_WSF + 1024;
constexpr int LDS_BYTES = 147456;
static_assert(2 * A_STAGE <= 131072 && A_QSLOT + 64 <= LDS_BYTES, "attention LDS map");

__device__ __forceinline__ void attn_unit(ldsp L, int bh, int qb, const bf16* __restrict__ dq, const bf16* __restrict__ dk, const bf16* __restrict__ dv, bf16* __restrict__ ya,
                                          const float* __restrict__ qn, const float* __restrict__ kn, const float* __restrict__ relb, const float* __restrict__ subln, float lam) {
    const int tid = threadIdx.x, lane = tid & 63, r32 = lane & 31, hi = lane >> 5, w = __builtin_amdgcn_readfirstlane(tid >> 6), j = w >> 2, qs = w & 3;
    const int b = bh >> 3, h = bh & 7, q0 = qb * 128, qrow0 = q0 + 32 * qs;
    const size_t tok0 = (size_t)b * SEQ;
    if (tid < 128) { const int d = tid; int bk = d;
        if (d >= 16) { bk = 16 + (int)(logf((float)d / 16.f) / 2.0794415416798357f * 16.f); bk = bk > 31 ? 31 : bk; }
        lds_st<float>(L + A_TAB + 4 * d, (relb[bk * 8 + h] - relb[31 * 8 + h]) * LOG2E); }
    const int kr = tid >> 3, c8 = tid & 7;
    const bf16* gk = dk + (tok0 + kr) * 1024 + h * 128 + 8 * c8;
    const bf16* gv = dv + (tok0 + kr) * 1024 + h * 128 + 8 * c8;
    u32x4 k0r = *(const u32x4*)gk, k1r = *(const u32x4*)(gk + 64), v0r = *(const u32x4*)gv, v1r = *(const u32x4*)(gv + 64);
    bf16x8 qr[4];
    { const bf16* qp = dq + (tok0 + qrow0 + r32) * 1024 + h * 128 + j * 64 + hi * 8;
      u32x4 raw[4];
#pragma unroll
      for (int d0 = 0; d0 < 4; ++d0) raw[d0] = *(const u32x4*)(qp + 16 * d0);
      const float rs = 0.125f * LOG2E;
#pragma unroll
      for (int d0 = 0; d0 < 4; ++d0) { u32x4 p;
#pragma unroll
          for (int i = 0; i < 4; ++i) { const int d = 16 * d0 + 8 * hi + 2 * i;
              p[i] = cvtpk(bflo(raw[d0][i]) * rs * qn[d] * kn[d], bfhi(raw[d0][i]) * rs * qn[d + 1] * kn[d + 1]); }
          qr[d0] = __builtin_bit_cast(bf16x8, p); } }
#define A_LOAD(t) do { const size_t o_ = (size_t)(t) * 64 * 1024; k0r = *(const u32x4*)(gk + o_); k1r = *(const u32x4*)(gk + o_ + 64); v0r = *(const u32x4*)(gv + o_); v1r = *(const u32x4*)(gv + o_ + 64); } while (0)
#define A_STORE(buf) do { ldsp s_ = L + (buf) * A_STAGE; lds_st<u32x4>(s_ + kr * A_KP + c8 * 16, k0r); lds_st<u32x4>(s_ + A_KT + kr * A_KP + c8 * 16, k1r); \
        lds_st<u32x4>(s_ + 2 * A_KT + kr * A_VP + c8 * 16, v0r); lds_st<u32x4>(s_ + 2 * A_KT + kr * A_VP + 128 + c8 * 16, v1r); } while (0)
    const int NT = 2 * qb + 2;
    A_STORE(0);
    A_LOAD(1);
    __syncthreads();
    f32x16 o[4]; o[0] = f32x16{}; o[1] = f32x16{}; o[2] = f32x16{}; o[3] = f32x16{};
    f32x16 lacc = f32x16{};
    const bf16x8 ones = (bf16x8){0x3F80, 0x3F80, 0x3F80, 0x3F80, 0x3F80, 0x3F80, 0x3F80, 0x3F80};
    const ldsp wsf = L + A_WSF + w * 128;
    const int qpos = qrow0 + r32;
    for (int t = 0; t < NT; ++t) {
        if (t + 1 < NT) A_STORE((t + 1) & 1);
        if (t + 2 < NT) A_LOAD(t + 2);
        const int kb = 64 * t;
        if (kb <= qrow0 + 31) {
            const ldsp Kj = L + (t & 1) * A_STAGE + j * A_KT + r32 * A_KP + hi * 16;
            f32x16 p0 = f32x16{}, p1 = f32x16{};
            __builtin_amdgcn_s_setprio(1);
#pragma unroll
            for (int d0 = 0; d0 < 4; ++d0) { const bf16x8 a0 = lds_ld<bf16x8>(Kj + d0 * 32), a1 = lds_ld<bf16x8>(Kj + 32 * A_KP + d0 * 32);
                p0 = MFMA32(a0, qr[d0], p0); p1 = MFMA32(a1, qr[d0], p1); }
            __builtin_amdgcn_s_setprio(0);
            if (kb + 63 + 128 > qrow0) {
#pragma unroll
                for (int r = 0; r < 16; ++r) { const int d = qpos - (kb + crow(r, hi)), d2 = d - 32;
                    const float b0 = lds_ld<float>(L + A_TAB + 4 * (d < 0 ? 0 : (d > 127 ? 127 : d))), b1 = lds_ld<float>(L + A_TAB + 4 * (d2 < 0 ? 0 : (d2 > 127 ? 127 : d2)));
                    p0[r] = d < 0 ? -1e30f : p0[r] + b0; p1[r] = d2 < 0 ? -1e30f : p1[r] + b1; }
            }
#pragma unroll
            for (int r = 0; r < 16; ++r) { p0[r] = __builtin_amdgcn_exp2f(p0[r]); p1[r] = __builtin_amdgcn_exp2f(p1[r]); }
            bf16x8 pa[4]; pa[0] = pack8(p0, 0); pa[1] = pack8(p0, 1); pa[2] = pack8(p1, 0); pa[3] = pack8(p1, 1);
            __builtin_amdgcn_s_setprio(1);
            lacc = MFMA32(pa[0], ones, lacc); lacc = MFMA32(pa[1], ones, lacc); lacc = MFMA32(pa[2], ones, lacc); lacc = MFMA32(pa[3], ones, lacc);
            const ldsp vbase = L + (t & 1) * A_STAGE + 2 * A_KT + (4 * hi + ((lane & 15) >> 2)) * A_VP + (16 * ((lane >> 4) & 1) + 4 * (lane & 3)) * 2;
#pragma unroll
            for (int s = 0; s < 4; ++s)
#pragma unroll
                for (int vb = 0; vb < 4; ++vb) { const s16x4 lo = tr_ld(vbase + s * 16 * A_VP + vb * 64), hh = tr_ld(vbase + s * 16 * A_VP + 8 * A_VP + vb * 64);
                    o[vb] = MFMA32(pa[s], cat4(lo, hh), o[vb]); }
            __builtin_amdgcn_s_setprio(0);
        }
        __syncthreads();
    }
#undef A_LOAD
#undef A_STORE
#pragma unroll
    for (int g = 0; g < 4; ++g) {
#pragma unroll
        for (int i = 0; i < 4; ++i) { const float inv = __builtin_amdgcn_rcpf(lacc[4 * g + i]);
#pragma unroll
            for (int vb = 0; vb < 4; ++vb) lds_st<float>(L + j * 65536 + ((qs * 32 + 8 * g + 4 * hi + i) * 128 + 32 * vb + r32) * 4, o[vb][4 * g + i] * inv); } }
    __syncthreads();
    { const int row = tid >> 2, qd = tid & 3; const ldsp e0 = L + (row * 128 + 32 * qd) * 4;
      float d[32]; float ssq = 0.f;
#pragma unroll
      for (int i = 0; i < 8; ++i) { const f32x4 a = lds_ld<f32x4>(e0 + 16 * i), c = lds_ld<f32x4>(e0 + 65536 + 16 * i);
#pragma unroll
          for (int k = 0; k < 4; ++k) { const float x = a[k] - lam * c[k]; d[4 * i + k] = x; ssq += x * x; } }
      ssq += DPP_F(ssq, 0xB1); ssq += DPP_F(ssq, 0x4E);
      const float rs = rsqrtf(ssq * (1.f / 128.f) + EPS) * 0.8f;
      bf16* yp = ya + (tok0 + q0 + row) * 1024 + h * 128 + 32 * qd;
#pragma unroll
      for (int i = 0; i < 4; ++i) { u32x4 wv;
#pragma unroll
          for (int k = 0; k < 4; ++k) { const int c = 8 * i + 2 * k; wv[k] = cvtpk(d[c] * rs * subln[32 * qd + c], d[c + 1] * rs * subln[32 * qd + c + 1]); }
          *(u32x4*)(yp + 8 * i) = wv; } }
    __syncthreads();
}

constexpr int H_QP = 272, H_TP = 80, H_VP = 320;
constexpr int H_QT = 0, H_KT = 32 * H_QP, H_KTT = 2 * 32 * H_QP, H_V = H_KTT + 128 * H_TP, H_DEC = H_V + 32 * H_VP, H_O = H_DEC + 512, H_BUF = H_O + 32 * 512;
static_assert(2 * H_BUF <= 131072, "hgrn LDS map");

__device__ __forceinline__ void hgrn_unit(ldsp L, int bh, const bf16* __restrict__ hq, const bf16* __restrict__ hf, const bf16* __restrict__ hv, const bf16* __restrict__ hg, bf16* __restrict__ yb,
                                          const float* __restrict__ lbl, const float* __restrict__ gnorm) {
    const int tid = threadIdx.x, lane = tid & 63, r32 = lane & 31, hi = lane >> 5, w = __builtin_amdgcn_readfirstlane(tid >> 6);
    const int b = bh >> 3, h = bh & 7;
    const size_t tok0 = (size_t)b * SEQ;
    const bool prep = w >= 4;
    const int pt = tid & 255, cpl = lane & 15, tq = lane >> 4, k0 = 2 * (16 * (w & 3) + cpl);
    const float lb0 = sigm(lbl[h * 128 + k0] - lbl[1024 + h * 128 + k0]), lb1 = sigm(lbl[h * 128 + k0 + 1] - lbl[1024 + h * 128 + k0 + 1]);
    const int vrow = pt >> 3, vc8 = pt & 7;
    f32x16 S[4]; S[0] = f32x16{}; S[1] = f32x16{}; S[2] = f32x16{}; S[3] = f32x16{};
    const int vb = w & 3;
    unsigned qw[8], fw[8]; u32x4 v0r = {0u, 0u, 0u, 0u}, v1r = {0u, 0u, 0u, 0u}, g0r = {0u, 0u, 0u, 0u}, g1r = {0u, 0u, 0u, 0u};
#pragma unroll
    for (int i = 0; i < 8; ++i) { qw[i] = 0u; fw[i] = 0u; }
    auto do_load = [&](int c) {
        const size_t base = (tok0 + 32 * c + 8 * tq) * 1024 + h * 128 + k0;
#pragma unroll
        for (int i = 0; i < 8; ++i) { qw[i] = *(const unsigned*)(hq + base + (size_t)i * 1024); fw[i] = *(const unsigned*)(hf + base + (size_t)i * 1024); }
        const bf16* vsrc = hv + (tok0 + 32 * c + vrow) * 1024 + h * 128 + 8 * vc8;
        v0r = *(const u32x4*)vsrc; v1r = *(const u32x4*)(vsrc + 64);
    };
    auto do_loadg = [&](int c) {
        const size_t off = (tok0 + 32 * c + (pt >> 3)) * 1024 + h * 128 + 16 * (pt & 7);
        g0r = *(const u32x4*)(hg + off); g1r = *(const u32x4*)(hg + off + 8);
    };
    auto do_prep = [&](int c) {
        const ldsp B = L + (c & 1) * H_BUF;
        const u32x4 v0 = v0r, v1 = v1r;
        float qt[2][8], kt[2][8];
#pragma unroll
        for (int ch = 0; ch < 2; ++ch) {
            const float lb = ch ? lb1 : lb0;
            float P = 1.f, Pl[8], kk[8];
#pragma unroll
            for (int i = 0; i < 8; ++i) { const float sg = ch ? bfhi(fw[i]) : bflo(fw[i]); const float f = lb + (1.f - lb) * sg; P *= f; Pl[i] = P; kk[i] = (1.f - lb) * (1.f - sg); }
            const float T0 = __shfl(P, cpl), T1 = __shfl(P, 16 + cpl), T2 = __shfl(P, 32 + cpl), T3 = __shfl(P, 48 + cpl);
            const float pre = tq == 0 ? 1.f : (tq == 1 ? T0 : (tq == 2 ? T0 * T1 : T0 * T1 * T2));
            if (tq == 0) lds_st<float>(B + H_DEC + 4 * (k0 + ch), (T0 * T1) * (T2 * T3));
#pragma unroll
            for (int i = 0; i < 8; ++i) { const float Pt = pre * Pl[i]; const float qv = ch ? bfhi(qw[i]) : bflo(qw[i]);
                qt[ch][i] = qv * Pt; kt[ch][i] = kk[i] * __builtin_amdgcn_rcpf(fmaxf(Pt, 1e-30f)); }
        }
#pragma unroll
        for (int i = 0; i < 8; ++i) { lds_st<unsigned>(B + H_QT + (8 * tq + i) * H_QP + k0 * 2, cvtpk(qt[0][i], qt[1][i])); lds_st<unsigned>(B + H_KT + (8 * tq + i) * H_QP + k0 * 2, cvtpk(kt[0][i], kt[1][i])); }
#pragma unroll
        for (int ch = 0; ch < 2; ++ch) { u32x4 t4; t4[0] = cvtpk(kt[ch][0], kt[ch][1]); t4[1] = cvtpk(kt[ch][2], kt[ch][3]); t4[2] = cvtpk(kt[ch][4], kt[ch][5]); t4[3] = cvtpk(kt[ch][6], kt[ch][7]);
            lds_st<u32x4>(B + H_KTT + (k0 + ch) * H_TP + 16 * tq, t4); }
        lds_st<u32x4>(B + H_V + vrow * H_VP + vc8 * 16, v0); lds_st<u32x4>(B + H_V + vrow * H_VP + 128 + vc8 * 16, v1);
    };
    auto do_final = [&](int c) {
        const ldsp Ob = L + (c & 1) * H_BUF + H_O;
        const int t = pt >> 3, v0 = 16 * (pt & 7);
        float ov[16]; float ssq = 0.f;
#pragma unroll
        for (int i = 0; i < 4; ++i) { const f32x4 a = lds_ld<f32x4>(Ob + (t * 128 + v0 + 4 * i) * 4);
#pragma unroll
            for (int k = 0; k < 4; ++k) { ov[4 * i + k] = a[k]; ssq += a[k] * a[k]; } }
        ssq += DPP_F(ssq, 0xB1); ssq += DPP_F(ssq, 0x4E); ssq += DPP_F(ssq, 0x141);
        const float rs = rsqrtf(ssq * (1.f / 128.f) + EPS);
        const size_t off = (tok0 + 32 * c + t) * 1024 + h * 128 + v0;
        const u32x4 g0 = g0r, g1 = g1r;
        u32x4 w0, w1;
#pragma unroll
        for (int k = 0; k < 4; ++k) { const float a = bflo(g0[k]), c2 = bfhi(g0[k]), a1 = bflo(g1[k]), c1 = bfhi(g1[k]);
            w0[k] = cvtpk(ov[2 * k] * rs * gnorm[v0 + 2 * k] * a, ov[2 * k + 1] * rs * gnorm[v0 + 2 * k + 1] * c2);
            w1[k] = cvtpk(ov[8 + 2 * k] * rs * gnorm[v0 + 8 + 2 * k] * a1, ov[8 + 2 * k + 1] * rs * gnorm[v0 + 8 + 2 * k + 1] * c1); }
        *(u32x4*)(yb + off) = w0; *(u32x4*)(yb + off + 8) = w1;
    };
    auto do_mfma = [&](int c) {
        const ldsp B = L + (c & 1) * H_BUF;
        const ldsp Qt = B + H_QT + r32 * H_QP, Kt = B + H_KT + r32 * H_QP;
        f32x16 D = f32x16{};
#pragma unroll
        for (int kk = 0; kk < 8; ++kk) { const bf16x8 a = lds_ld<bf16x8>(Kt + (16 * kk + 8 * hi) * 2), bq = lds_ld<bf16x8>(Qt + (16 * kk + 8 * hi) * 2); D = MFMA32(a, bq, D); }
#pragma unroll
        for (int r = 0; r < 16; ++r) if (crow(r, hi) > r32) D[r] = 0.f;
        const bf16x8 aD0 = pack8(D, 0), aD1 = pack8(D, 1);
        const ldsp vbase = B + H_V + ((lane & 15) >> 2) * H_VP + (32 * vb + 16 * ((lane >> 4) & 1) + 4 * (lane & 3)) * 2;
        f32x16 o = f32x16{};
        { const s16x4 lo = tr_ld(vbase + (4 * hi) * H_VP), hh = tr_ld(vbase + (8 + 4 * hi) * H_VP); o = MFMA32(aD0, cat4(lo, hh), o); }
        { const s16x4 lo = tr_ld(vbase + (16 + 4 * hi) * H_VP), hh = tr_ld(vbase + (24 + 4 * hi) * H_VP); o = MFMA32(aD1, cat4(lo, hh), o); }
#pragma unroll
        for (int kb = 0; kb < 4; ++kb)
#pragma unroll
            for (int s2 = 0; s2 < 2; ++s2) { const u32x2 q1 = lds_ld<u32x2>(Qt + (32 * kb + 16 * s2 + 4 * hi) * 2), q2 = lds_ld<u32x2>(Qt + (32 * kb + 16 * s2 + 8 + 4 * hi) * 2);
                const u32x4 qa = {q1[0], q1[1], q2[0], q2[1]};
                o = MFMA32(__builtin_bit_cast(bf16x8, qa), pack8(S[kb], s2), o); }
        const ldsp Ob = B + H_O;
#pragma unroll
        for (int r = 0; r < 16; ++r) lds_st<float>(Ob + (crow(r, hi) * 128 + 32 * vb + r32) * 4, o[r]);
#pragma unroll
        for (int kb = 0; kb < 4; ++kb) {
#pragma unroll
            for (int s2 = 0; s2 < 2; ++s2) { const bf16x8 ka = lds_ld<bf16x8>(B + H_KTT + (32 * kb + r32) * H_TP + (16 * s2 + 8 * hi) * 2);
                const s16x4 lo = tr_ld(vbase + (16 * s2 + 8 * hi) * H_VP), hh = tr_ld(vbase + (16 * s2 + 8 * hi + 4) * H_VP);
                S[kb] = MFMA32(ka, cat4(lo, hh), S[kb]); }
#pragma unroll
            for (int g = 0; g < 4; ++g) { const f32x4 d4 = lds_ld<f32x4>(B + H_DEC + (32 * kb + 8 * g + 4 * hi) * 4);
#pragma unroll
                for (int i = 0; i < 4; ++i) S[kb][4 * g + i] *= d4[i]; }
        }
    };
    if (prep) { do_load(0); do_prep(0); do_load(1); }
    __syncthreads();
    for (int c = 0; c < 64; ++c) {
        if (prep) {
            if (c + 1 < 64) do_prep(c + 1);
            if (c + 2 < 64) do_load(c + 2);
            if (c > 0) do_final(c - 1);
            do_loadg(c);
        }
        else do_mfma(c);
        __syncthreads();
    }
    if (prep) do_final(63);
    __syncthreads();
}

struct Args { const float* in[29]; float* out; unsigned char* ws; int ph_lo, ph_hi; };
constexpr int N_PHASES = 10;
constexpr size_t WS_BAR = 512 * 1024;
constexpr int LDS_BARST = 133120;

__global__ void __launch_bounds__(512, 2) fwd_megakernel(Args a) {
    extern __shared__ __attribute__((aligned(16))) unsigned char lds_raw[];
    const ldsp L = (ldsp)lds_raw;
    PG8_LAS unsigned char* const LG = (PG8_LAS unsigned char*)lds_raw;
    cg::grid_group grid = cg::this_grid();
    const int tid = threadIdx.x, lane = tid & 63, wave = __builtin_amdgcn_readfirstlane(tid >> 6);
    const int G = gridDim.x, bx = blockIdx.x;
    unsigned char* ws = a.ws;
    float* ctl = (float*)(ws + WS_CTL);
    bf16* Win_t = (bf16*)(ws + WS_WIN); bf16* Wgu_t = (bf16*)(ws + WS_WGU); bf16* Wd_t = (bf16*)(ws + WS_WD);
    bf16* Wa_t = (bf16*)(ws + WS_WA); bf16* Wb_t = (bf16*)(ws + WS_WB); bf16* Wo_t = (bf16*)(ws + WS_WO); bf16* Wpg_t = (bf16*)(ws + WS_WPG); bf16* Wpp_t = (bf16*)(ws + WS_WPP); bf16* PB = (bf16*)(ws + WS_PB);
    bf16* XB = (bf16*)(ws + WS_XB); bf16* YA = XB; bf16* YB = XB + (size_t)TOK * 1024;
    bf16* ACT = (bf16*)(ws + WS_BIG); bf16* PROJ = ACT; bf16* GAB = (bf16*)(ws + WS_BIG + BIG_GA); bf16* MERGED = ACT; bf16* PLE = (bf16*)(ws + WS_BIG + BIG_PLE);
    float* OUT = a.out;
    const int lo = a.ph_lo, hi_ = a.ph_hi;
    if (tid < 4) lds_st<unsigned>(L + LDS_BARST + 4 * tid, 0u);
    __syncthreads();
    XcdBarrier xbar; xbar.bar = (unsigned*)(ws + WS_BAR); xbar.x = 0; xbar.st = nullptr;
    if (hi_ - lo > 1) xbar = xcd_barrier_post((unsigned*)(ws + WS_BAR), (volatile LAS unsigned*)(L + LDS_BARST));
    if (lo < 0) grid.sync();
#define IN(k) (lo <= (k) && (k) < hi_)
#define SEAM(k) do { if (IN(k) && IN((k) + 1)) xcd_barrier(xbar); } while (0)
#define RUN_GEMM(EPI, Aptr, Bptr, N_, K_, Eobj) do { pg8::Gemm g_{(const pg8::bf16_t*)(Aptr), (const pg8::bf16_t*)(Bptr), TOK, (N_), (K_)}; pg8::StaticOrder S_; S_.init(TOK, (N_), G, bx); \
        pg8::gemm_phase<EPI, pg8::StaticOrder, true, true>(LG, g_, S_, Eobj); } while (0)

    if (IN(0)) {
        const int gw = bx * 8 + wave, NGW = G * 8;
        for (int i = bx * 512 + tid; i < C_ZERO_END - C_SS2; i += G * 512) ctl[C_SS2 + i] = 0.f;
        const ldsp scr = L + wave * 16384;
        constexpr int I_GU = (DM / 64) * (FF / 32), I_D = (FF / 64) * (DM / 32), I_IN = (DM / 64) * (NIN / 32);
        for (int it = gw; it < 2 * I_GU + I_D + I_IN; it += NGW) {
            int r = it;
            if (r < I_GU) { transpose_item(a.in[3], DM, FF, a.in[2], Wgu_t, 1, scr, r, lane); continue; } r -= I_GU;
            if (r < I_GU) { transpose_item(a.in[4], DM, FF, a.in[2], Wgu_t, 2, scr, r, lane); continue; } r -= I_GU;
            if (r < I_D) { transpose_item(a.in[5], FF, DM, nullptr, Wd_t, 0, scr, r, lane); continue; } r -= I_D;
            transpose_item(a.in[7], DM, NIN, a.in[6], Win_t, 3, scr, r, lane);
        }
        for (int m = gw; m < TOK; m += NGW) {
            const f32x4* xr = (const f32x4*)(a.in[0] + (size_t)m * DM) + lane;
            f32x4 v[8]; float s = 0.f;
#pragma unroll
            for (int j = 0; j < 8; ++j) { v[j] = __builtin_nontemporal_load(xr + 64 * j); s += (v[j][0] * v[j][0] + v[j][1] * v[j][1]) + (v[j][2] * v[j][2] + v[j][3] * v[j][3]); }
            s = wave_sum(s);
            if (lane == 0) ctl[C_SS1 + m] = s;
            u32x2* o8 = (u32x2*)(XB + (size_t)m * DM) + lane;
#pragma unroll
            for (int j = 0; j < 8; ++j) { u32x2 w2; w2[0] = cvtpk(v[j][0], v[j][1]); w2[1] = cvtpk(v[j][2], v[j][3]); o8[64 * j] = w2; }
        }
    }
    SEAM(0);
    if (IN(1)) { EpiSwiglu E{ACT, ctl + C_SS1}; RUN_GEMM(EpiSwiglu, XB, Wgu_t, 2 * FF, DM, E); }
    SEAM(1);
    if (IN(2)) { EpiResid E{a.in[0], OUT, XB, ctl + C_SS2, 0.5f}; RUN_GEMM(EpiResid, ACT, Wd_t, DM, FF, E); }
    SEAM(2);
    if (IN(3)) { EpiProj E{PROJ, GAB, ctl + C_SS2}; RUN_GEMM(EpiProj, XB, Win_t, NIN, DM, E); }
    SEAM(3);
    if (IN(4)) {
        const size_t PS = (size_t)TOK * 1024;
        if (bx < 64 && G > 64) {
            hgrn_unit(L, bx, PROJ + 3 * PS, PROJ + 4 * PS, PROJ + 5 * PS, PROJ + 6 * PS, YB, a.in[16], a.in[17]);
        } else {
            if (G <= 64) { for (int u = bx; u < 64; u += G) hgrn_unit(L, u, PROJ + 3 * PS, PROJ + 4 * PS, PROJ + 5 * PS, PROJ + 6 * PS, YB, a.in[16], a.in[17]); }
            const int nb0 = (G > 64) ? 64 : 0;
            const int gw = (bx - nb0) * 8 + wave, NGW = (G - nb0) * 8;
            const ldsp scr = L + wave * 16384;
            constexpr int I_A = (1024 / 64) * (DM / 32), I_O = (DM / 64) * (DM / 32), I_PP = (256 / 64) * (DM / 32), I_GU = (DM / 64) * (FF / 32), I_D = (FF / 64) * (DM / 32);
            for (int it = gw; it < 2 * I_A + 2 * I_O + I_PP + 2 * I_GU + I_D; it += NGW) {
                int r = it;
                if (r < I_A) { transpose_item(a.in[18], 1024, DM, nullptr, Wa_t, 0, scr, r, lane); continue; } r -= I_A;
                if (r < I_A) { transpose_item(a.in[19], 1024, DM, nullptr, Wb_t, 0, scr, r, lane); continue; } r -= I_A;
                if (r < I_O) { transpose_item(a.in[20], DM, DM, nullptr, Wo_t, 0, scr, r, lane); continue; } r -= I_O;
                if (r < I_O) { transpose_item(a.in[26], DM, DM, a.in[25], Wpg_t, 0, scr, r, lane); continue; } r -= I_O;
                if (r < I_PP) { transpose_item(a.in[27], 256, DM, nullptr, Wpp_t, 0, scr, r, lane); continue; } r -= I_PP;
                if (r < I_GU) { transpose_item(a.in[22], DM, FF, a.in[21], Wgu_t, 1, scr, r, lane); continue; } r -= I_GU;
                if (r < I_GU) { transpose_item(a.in[23], DM, FF, a.in[21], Wgu_t, 2, scr, r, lane); continue; } r -= I_GU;
                transpose_item(a.in[24], FF, DM, nullptr, Wd_t, 0, scr, r, lane);
            }
            for (int i = (bx - nb0) * 512 + tid; i < TOK * 256 / 8; i += (G - nb0) * 512) {
                const f32x4 p0 = __builtin_nontemporal_load((const f32x4*)(a.in[1] + (size_t)i * 8)), p1 = __builtin_nontemporal_load((const f32x4*)(a.in[1] + (size_t)i * 8 + 4));
                u32x4 w4; w4[0] = cvtpk(p0[0], p0[1]); w4[1] = cvtpk(p0[2], p0[3]); w4[2] = cvtpk(p1[0], p1[1]); w4[3] = cvtpk(p1[2], p1[3]);
                *(u32x4*)(PB + (size_t)i * 8) = w4;
            }
        }
        __syncthreads();
        float lam;
        { float s1 = 0.f, s2 = 0.f;
          for (int i = 0; i < 64; ++i) { s1 += a.in[10][i] * a.in[11][i]; s2 += a.in[12][i] * a.in[13][i]; }
          lam = expf(s1) - expf(s2) + 0.2f; }
        unsigned* queue = (unsigned*)(ctl + C_QUEUE);
        int qx = (int)(xb_xcc_id() & 7u), tries = 0;
        auto pop = [&]() -> unsigned {
            while (tries < 8) { const unsigned i = atomicAdd(queue + 16 * qx, 1u); if (i < 128u) return ((unsigned)qx << 7) | i; qx = (qx + 1) & 7; ++tries; }
            return 0xffffffffu; };
        if (tid == 0) lds_st<unsigned>(L + A_QSLOT, pop());
        __syncthreads();
        for (;;) {
            const unsigned u = lds_ld<unsigned>(L + A_QSLOT);
            if (u == 0xffffffffu) break;
            unsigned nxt = 0u;
            if (tid == 0) nxt = pop();
            attn_unit(L, (int)((u >> 7) + 8u * (u & 7u)), 15 - (int)((u >> 3) & 15u), PROJ, PROJ + PS, PROJ + 2 * PS, YA, a.in[8], a.in[9], a.in[15], a.in[14], lam);
            if (tid == 0) lds_st<unsigned>(L + A_QSLOT, nxt);
            __syncthreads();
        }
    }
    SEAM(4);
    if (IN(5)) {
        static_assert(WS_WB == WS_WA + (size_t)DM * 1024 * 2, "Wa_t and Wb_t are contiguous");
        pg8::Gemm g_{(const pg8::bf16_t*)YA, (const pg8::bf16_t*)Wa_t, 2 * TOK, 2 * DM, 1024}; MergeOrder S_; S_.init(G, bx);
        EpiMerge2 E{GAB, GAB + (size_t)TOK * 2048, MERGED};
        pg8::gemm_phase<EpiMerge2, MergeOrder, true, true>(LG, g_, S_, E);
    }
    SEAM(5);
    if (IN(6)) { EpiResid E{OUT, OUT, XB, ctl + C_SS3, 1.0f}; RUN_GEMM(EpiResid, MERGED, Wo_t, DM, DM, E); }
    SEAM(6);
    if (IN(7)) {
        { EpiSwiglu E{ACT, ctl + C_SS3}; RUN_GEMM(EpiSwiglu, XB, Wgu_t, 2 * FF, DM, E); }
        { int kple = 256; asm volatile("" : "+s"(kple)); EpiPle E{PLE, ctl + C_SSP}; RUN_GEMM(EpiPle, PB, Wpp_t, DM, kple, E); }
    }
    SEAM(7);
    if (IN(8)) { EpiResid E{OUT, OUT, XB, ctl + C_SS4, 0.5f}; RUN_GEMM(EpiResid, ACT, Wd_t, DM, FF, E); }
    SEAM(8);
    if (IN(9)) { EpiFinal E{OUT, PLE, ctl + C_SS4, ctl + C_SSP, a.in[28]}; RUN_GEMM(EpiFinal, XB, Wpg_t, DM, DM, E); }
#undef IN
#undef SEAM
#undef RUN_GEMM
}

#ifndef MK_PER_PHASE
#define MK_PER_PHASE 0
#endif
extern "C" void kernel_launch(void* const* d_in, const int* in_sizes, int n_in, void* d_out, int out_size, void* d_ws, size_t ws_size, hipStream_t stream) {
    static int grid = 0;
    if (grid == 0) {
        if (n_in != 29 || out_size != TOK * DM || ws_size < WS_END) { fprintf(stderr, "kernel_launch: unexpected problem: n_in %d out %d ws %zu (need >= %zu)\n", n_in, out_size, ws_size, (size_t)WS_END); grid = -1; return; }
        int dev = 0, cus = 0, per_cu = 0;
        (void)hipGetDevice(&dev); (void)hipDeviceGetAttribute(&cus, hipDeviceAttributeMultiprocessorCount, dev);
        if (hipFuncSetAttribute((const void*)fwd_megakernel, hipFuncAttributeMaxDynamicSharedMemorySize, LDS_BYTES) != hipSuccess) { fprintf(stderr, "kernel_launch: hipFuncSetAttribute failed\n"); grid = -1; return; }
        if (hipOccupancyMaxActiveBlocksPerMultiprocessor(&per_cu, (const void*)fwd_megakernel, 512, LDS_BYTES) != hipSuccess || per_cu < 1) { fprintf(stderr, "kernel_launch: occupancy query says %d\n", per_cu); per_cu = 1; }
        (void)hipGetLastError();
        grid = cus;
        if (grid <= 0) grid = 256;
    }
    if (grid < 0) return;
    if (hipMemsetAsync((char*)d_ws + WS_BAR, 0, 16384, stream) != hipSuccess) { fprintf(stderr, "kernel_launch: memset failed\n"); return; }
    Args a{};
    for (int i = 0; i < 29; ++i) a.in[i] = (const float*)d_in[i];
    a.out = (float*)d_out; a.ws = (unsigned char*)d_ws;
#if MK_PER_PHASE
    for (int p = 0; p < N_PHASES; ++p) { a.ph_lo = p; a.ph_hi = p + 1; hipLaunchKernelGGL(fwd_megakernel, dim3(grid), dim3(512), LDS_BYTES, stream, a); }
#else
    a.ph_lo = 0; a.ph_hi = N_PHASES;
    void* args[] = {&a};
    hipError_t e = hipLaunchCooperativeKernel((const void*)fwd_megakernel, dim3(grid), dim3(512), args, LDS_BYTES, stream);
    if (e != hipSuccess) fprintf(stderr, "kernel_launch: cooperative launch failed: %s (grid %d)\n", hipGetErrorString(e), grid);
#endif
}
```

```cpp
#include <hip/hip_runtime.h>
#include <hip/hip_cooperative_groups.h>
#include <cstdio>
#include <cstdint>
namespace cg = cooperative_groups;
namespace pg8 {
#define PG8_LAS __attribute__((address_space(3)))
typedef unsigned short bf16_t;
typedef short bf16x8 __attribute__((ext_vector_type(8)));
typedef float f32x4 __attribute__((ext_vector_type(4)));
typedef unsigned u32x4 __attribute__((ext_vector_type(4)));
constexpr int BM = 256, BK = 64, HALF = 128, HTB = HALF * BK * 2  , STAGE_BYTES = 8 * HTB, NXCD = 8, WGM = 4;

__host__ __device__ __forceinline__ int lds_byte(int r, int c) { const int st = (r >> 4) * 2 + (c >> 5), rr = r & 15, cc = c & 31, ob = rr * 64 + cc * 2; return st * 1024 + (ob ^ (((ob >> 9) & 1) << 5)); }
__host__ __device__ __forceinline__ void stage_rc(int b, int& R, int& C) { const int st = b / 1024, sb = b % 1024, swz = sb ^ (((sb >> 9) & 1) << 5); R = (st >> 1) * 16 + swz / 64; C = (st & 1) * 32 + (swz % 64) / 2; }
__host__ __device__ __forceinline__ int perm32(int rho) { const int n = rho >> 4, i = rho & 15; return 8 * (i >> 2) + 4 * n + (i & 3); }

struct Unit { int pm, pn; };
struct Gemm { const bf16_t* A; const bf16_t* Bt; int M, N, K; };

struct StaticOrder {
    int nM, nN, nwg, G, c;
    __host__ __device__ void init(int M, int N, int G_, int c_) { nM = M / BM; nN = N / BM; nwg = nM * nN; G = G_; c = c_; }
    __host__ __device__ bool next(int i, Unit& u) const {
        const long L = (long)i * G + c; if (L >= nwg) return false;
        int wgid = (int)L; { const int q = nwg / NXCD, r = nwg % NXCD, xcd = wgid % NXCD, off = wgid / NXCD; wgid = (xcd < r ? xcd * (q + 1) : r * (q + 1) + (xcd - r) * q) + off; }
        const int nig = WGM * nN, gid = wgid / nig, fm = gid * WGM, gsz = (nM - fm) < WGM ? (nM - fm) : WGM;
        u.pm = fm + ((wgid % nig) % gsz); u.pn = (wgid % nig) / gsz; return true;
    }
    __device__ __forceinline__ void a_ready(const Unit&) const {}
    __device__ __forceinline__ void done(const Unit&) const {}
};

__device__ __forceinline__ unsigned cvt_pk_bf16(float lo, float hi) { unsigned r; asm volatile("v_cvt_pk_bf16_f32 %0, %1, %2" : "=v"(r) : "v"(lo), "v"(hi)); return r; }
typedef float f32x2 __attribute__((ext_vector_type(2)));
template <class Epi, class Sched, bool ALIGN_EPI = false, bool SP2 = false>
__device__ __forceinline__ void gemm_phase(PG8_LAS unsigned char* lds, const Gemm g, const Sched& S, const Epi& E) {
    const int tid = threadIdx.x, wid = __builtin_amdgcn_readfirstlane(tid >> 6), lane = tid & 63, wr = wid >> 2, wc = wid & 3, fr = lane & 15, fq = lane >> 4;
    const int K = g.K, nt = K / BK;
    unsigned voffA[2], voffB[2];
#pragma unroll
    for (int i = 0; i < 2; ++i) { int R, C; stage_rc(tid * 16 + i * 8192, R, C); const int Rb = Epi::PERM ? ((R & ~31) + perm32(R & 31)) : R;
        voffA[i] = (unsigned)(R * K + C) * 2u; voffB[i] = (unsigned)(Rb * K + C) * 2u; }
    const size_t kstep = (size_t)(BK * 2);
    const size_t hstep = (size_t)HALF * K * 2;
    const size_t tstep = 2 * hstep;
    const unsigned ldsw = (unsigned)wid * 1024u;
    const int aoff = lds_byte(wr * 64 + fr, fq * 8), boff = lds_byte(wc * 32 + fr, fq * 8);
#define PG8_SA(b, h) (((b) * 2 + (h)) * HTB)
#define PG8_SB(b, h) ((4 + (b) * 2 + (h)) * HTB)
#define PG8_STAGE(bufoff, gbase, voff) do { _Pragma("unroll") for (int _i = 0; _i < 2; ++_i) \
        __builtin_amdgcn_global_load_lds((const unsigned*)((const char*)(gbase) + (voff)[_i]), (PG8_LAS unsigned*)(lds + (bufoff) + ldsw + _i * 8192), 16, 0, 0); } while (0)
#define PG8_LDA(dst, b, h) do { _Pragma("unroll") for (int m = 0; m < 4; ++m) _Pragma("unroll") for (int k = 0; k < 2; ++k) dst[m][k] = *(const PG8_LAS bf16x8*)(lds + PG8_SA(b, h) + aoff + m * 2048 + k * 1024); } while (0)
#define PG8_LDB(dst, b, h) do { _Pragma("unroll") for (int n = 0; n < 2; ++n) _Pragma("unroll") for (int k = 0; k < 2; ++k) dst[n][k] = *(const PG8_LAS bf16x8*)(lds + PG8_SB(b, h) + boff + n * 2048 + k * 1024); } while (0)
#define PG8_MMA(ai, bj, At, Bt) do { __builtin_amdgcn_s_setprio(1); _Pragma("unroll") for (int m = 0; m < 4; ++m) _Pragma("unroll") for (int n = 0; n < 2; ++n) _Pragma("unroll") for (int k = 0; k < 2; ++k) \
        acc[ai][bj][m][n] = __builtin_amdgcn_mfma_f32_16x16x32_bf16(Bt[n][k], At[m][k], acc[ai][bj][m][n], 0, 0, 0); __builtin_amdgcn_s_setprio(0); } while (0)
#define PG8_WAIT_V(n) asm volatile("s_waitcnt vmcnt(" #n ")" ::: "memory")
#define PG8_WAIT_L(n) asm volatile("s_waitcnt lgkmcnt(" #n ")" ::: "memory")
#define PG8_BAR __builtin_amdgcn_s_barrier()
#define PG8_SCHED __builtin_amdgcn_sched_barrier(0)
    Unit cur, nxt; int ui = 0;
    if (!S.next(0, cur)) return;
    f32x4 acc[2][2][4][2];
#pragma unroll
    for (int a = 0; a < 2; ++a)
#pragma unroll
        for (int b = 0; b < 2; ++b)
#pragma unroll
            for (int m = 0; m < 4; ++m)
#pragma unroll
                for (int n = 0; n < 2; ++n) acc[a][b][m][n] = (f32x4){0.f, 0.f, 0.f, 0.f};
    bf16x8 At[4][2], B0[2][2], B1[2][2];
    const char* cA = (const char*)g.A + (size_t)cur.pm * tstep; const char* cB = (const char*)g.Bt + (size_t)cur.pn * tstep;
    S.a_ready(cur);
    if constexpr (SP2) {
        PG8_STAGE(PG8_SB(0, 0), cB, voffB); PG8_STAGE(PG8_SB(0, 1), cB + hstep, voffB); PG8_STAGE(PG8_SA(0, 0), cA, voffA); PG8_STAGE(PG8_SA(0, 1), cA + hstep, voffA);
        if (wr == 1) PG8_BAR;
        PG8_WAIT_V(2); PG8_BAR;
        PG8_STAGE(PG8_SB(1, 0), cB + kstep, voffB); PG8_STAGE(PG8_SA(1, 0), cA + kstep, voffA); PG8_STAGE(PG8_SB(1, 1), cB + hstep + kstep, voffB);
        PG8_WAIT_V(6); PG8_BAR;
    } else {
        PG8_STAGE(PG8_SB(0, 0), cB, voffB); PG8_STAGE(PG8_SA(0, 0), cA, voffA); PG8_STAGE(PG8_SB(0, 1), cB + hstep, voffB); PG8_STAGE(PG8_SA(0, 1), cA + hstep, voffA);
        if (wr == 1) PG8_BAR;
        PG8_WAIT_V(4); PG8_BAR;
        PG8_STAGE(PG8_SB(1, 0), cB + kstep, voffB); PG8_STAGE(PG8_SA(1, 0), cA + kstep, voffA); PG8_STAGE(PG8_SB(1, 1), cB + hstep + kstep, voffB);
        PG8_WAIT_V(6); PG8_BAR;
    }
    for (;;) {
        const bool has_next = S.next(ui + 1, nxt);
        const char* nA = has_next ? (const char*)g.A + (size_t)nxt.pm * tstep : cA; const char* nB = has_next ? (const char*)g.Bt + (size_t)nxt.pn * tstep : cB;
        for (int t = 0; t < nt; t += 2) {
            const bool last = (t == nt - 2);
            const char* a1 = cA + (size_t)(t + 1) * kstep;
            const char* a2 = last ? nA : cA + (size_t)(t + 2) * kstep; const char* b2 = last ? nB : cB + (size_t)(t + 2) * kstep;
            const char* a3 = a2 + kstep; const char* b3 = b2 + kstep;
            if (last && has_next) S.a_ready(nxt);
            if constexpr (SP2) {
            PG8_LDB(B0, 0, 0); PG8_LDB(B1, 0, 1); PG8_SCHED; PG8_LDA(At, 0, 0); PG8_STAGE(PG8_SA(1, 1), a1 + hstep, voffA);
            PG8_WAIT_V(8); PG8_WAIT_L(0); PG8_BAR; PG8_MMA(0, 0, At, B0); PG8_MMA(0, 1, At, B1); PG8_BAR; PG8_SCHED;
            PG8_LDA(At, 0, 1); PG8_STAGE(PG8_SB(0, 0), b2, voffB); PG8_STAGE(PG8_SB(0, 1), b2 + hstep, voffB); PG8_STAGE(PG8_SA(0, 0), a2, voffA);
            PG8_WAIT_V(8); PG8_WAIT_L(0); PG8_BAR; PG8_MMA(1, 0, At, B0); PG8_MMA(1, 1, At, B1); PG8_BAR; PG8_SCHED;
            PG8_LDB(B0, 1, 0); PG8_LDB(B1, 1, 1); PG8_SCHED; PG8_LDA(At, 1, 0); PG8_STAGE(PG8_SA(0, 1), a2 + hstep, voffA);
            PG8_WAIT_V(8); PG8_WAIT_L(0); PG8_BAR; PG8_MMA(0, 0, At, B0); PG8_MMA(0, 1, At, B1); PG8_BAR; PG8_SCHED;
            PG8_LDA(At, 1, 1); PG8_STAGE(PG8_SB(1, 0), b3, voffB); PG8_STAGE(PG8_SB(1, 1), b3 + hstep, voffB); PG8_STAGE(PG8_SA(1, 0), a3, voffA);
            PG8_WAIT_V(8); PG8_WAIT_L(0); PG8_BAR; PG8_MMA(1, 0, At, B0); PG8_MMA(1, 1, At, B1); PG8_BAR; PG8_SCHED;
            } else {
            PG8_LDB(B0, 0, 0); PG8_SCHED; PG8_LDA(At, 0, 0); PG8_STAGE(PG8_SA(1, 1), a1 + hstep, voffA);
            PG8_WAIT_L(8); PG8_BAR; PG8_WAIT_L(0); PG8_MMA(0, 0, At, B0); PG8_BAR; PG8_SCHED;
            PG8_LDB(B1, 0, 1); PG8_STAGE(PG8_SB(0, 0), b2, voffB);
            PG8_BAR; PG8_WAIT_L(0); PG8_MMA(0, 1, At, B1); PG8_BAR;
            PG8_LDA(At, 0, 1); PG8_STAGE(PG8_SA(0, 0), a2, voffA);
            PG8_BAR; PG8_WAIT_L(0); PG8_MMA(1, 0, At, B0); PG8_BAR; PG8_SCHED;
            PG8_STAGE(PG8_SB(0, 1), b2 + hstep, voffB);
            PG8_WAIT_V(6); PG8_BAR; PG8_MMA(1, 1, At, B1); PG8_BAR;
            PG8_LDB(B0, 1, 0); PG8_SCHED; PG8_LDA(At, 1, 0); PG8_STAGE(PG8_SA(0, 1), a2 + hstep, voffA);
            PG8_WAIT_L(8); PG8_BAR; PG8_WAIT_L(0); PG8_MMA(0, 0, At, B0); PG8_BAR; PG8_SCHED;
            PG8_LDB(B1, 1, 1); PG8_STAGE(PG8_SB(1, 0), b3, voffB);
            PG8_BAR; PG8_WAIT_L(0); PG8_MMA(0, 1, At, B1); PG8_BAR;
            PG8_LDA(At, 1, 1); PG8_STAGE(PG8_SA(1, 0), a3, voffA);
            PG8_BAR; PG8_WAIT_L(0); PG8_MMA(1, 0, At, B0); PG8_BAR; PG8_SCHED;
            PG8_STAGE(PG8_SB(1, 1), b3 + hstep, voffB);
            PG8_WAIT_V(6); PG8_BAR; PG8_MMA(1, 1, At, B1); PG8_BAR;
            }
        }
        if constexpr (ALIGN_EPI) { if (wr == 0) PG8_BAR; }
        if constexpr (!Epi::AFTER_DRAIN) { E(acc, cur, wr, wc, fr, fq); S.done(cur); }
        if (!has_next) break;
#pragma unroll
        for (int a = 0; a < 2; ++a)
#pragma unroll
            for (int b = 0; b < 2; ++b)
#pragma unroll
                for (int m = 0; m < 4; ++m)
#pragma unroll
                    for (int n = 0; n < 2; ++n) acc[a][b][m][n] = (f32x4){0.f, 0.f, 0.f, 0.f};
        cur = nxt; cA = nA; cB = nB; ++ui;
        if constexpr (ALIGN_EPI) { if (wr == 1) PG8_BAR; }
    }
    PG8_WAIT_V(0);
    if constexpr (!ALIGN_EPI) { if (wr == 0) PG8_BAR; }
    PG8_BAR;
    if constexpr (Epi::AFTER_DRAIN) { E.fused(acc, cur, wr, wc, fr, fq, lds, wid, lane); S.done(cur); }
#undef PG8_SA
#undef PG8_SB
#undef PG8_STAGE
#undef PG8_LDA
#undef PG8_LDB
#undef PG8_MMA
#undef PG8_WAIT_V
#undef PG8_WAIT_L
#undef PG8_BAR
#undef PG8_SCHED
}
}

constexpr int TOK = 16384, DM = 2048, FF = 5632, NIN = 11264, SEQ = 2048;
constexpr float EPS = 1e-6f, LOG2E = 1.4426950408889634f;
constexpr size_t MiB = (size_t)1 << 20;
constexpr size_t WS_CTL = 0;
constexpr size_t WS_WIN = 1 * MiB;
constexpr size_t WS_WA = 1 * MiB, WS_WB = 5 * MiB, WS_WO = 9 * MiB, WS_WPG = 17 * MiB, WS_WPP = 25 * MiB, WS_PB = 26 * MiB;
constexpr size_t WS_WGU = 45 * MiB;
constexpr size_t WS_WD = 89 * MiB;
constexpr size_t WS_XB = 111 * MiB;
constexpr size_t WS_BIG = 175 * MiB;
constexpr size_t WS_END = 527 * MiB;
constexpr size_t BIG_GA = 224 * MiB, BIG_PLE = 176 * MiB;
constexpr int C_SS1 = 0, C_SS2 = 16384, C_SS3 = 32768, C_SS4 = 49152, C_SSP = 65536, C_QUEUE = 81920, C_ZERO_END = 82048;

typedef unsigned short bf16;
#define LAS __attribute__((address_space(3)))
typedef LAS unsigned char* ldsp;
typedef float f32x4 __attribute__((ext_vector_type(4)));
typedef float f32x16 __attribute__((ext_vector_type(16)));
typedef unsigned u32x4 __attribute__((ext_vector_type(4)));
typedef unsigned u32x2 __attribute__((ext_vector_type(2)));
typedef short bf16x8 __attribute__((ext_vector_type(8)));
typedef short s16x4 __attribute__((ext_vector_type(4)));
typedef float f32x2_t __attribute__((ext_vector_type(2)));
typedef __bf16 bf16x2_t __attribute__((ext_vector_type(2)));

template <class T> __device__ __forceinline__ T lds_ld(ldsp p) { return *(const LAS T*)p; }
template <class T> __device__ __forceinline__ void lds_st(ldsp p, T v) { *(LAS T*)p = v; }
__device__ __forceinline__ unsigned cvtpk(float lo, float hi) { f32x2_t v = {lo, hi}; bf16x2_t b = __builtin_convertvector(v, bf16x2_t); return __builtin_bit_cast(unsigned, b); }
__device__ __forceinline__ float bflo(unsigned w) { return __uint_as_float(w << 16); }
__device__ __forceinline__ float bfhi(unsigned w) { return __uint_as_float(w & 0xffff0000u); }
__device__ __forceinline__ float sigm(float x) { return __builtin_amdgcn_rcpf(1.f + __builtin_amdgcn_exp2f(-x * LOG2E)); }
__device__ __forceinline__ int crow(int r, int hi) { return (r & 3) + 8 * (r >> 2) + 4 * hi; }
__device__ __forceinline__ s16x4 tr_ld(ldsp p) { typedef short v4i16_t __attribute__((ext_vector_type(4))); return __builtin_bit_cast(s16x4, __builtin_amdgcn_ds_read_tr16_b64_v4i16((LAS v4i16_t*)p)); }
__device__ __forceinline__ bf16x8 cat4(s16x4 a, s16x4 b) { return (bf16x8){a[0], a[1], a[2], a[3], b[0], b[1], b[2], b[3]}; }
__device__ __forceinline__ bf16x8 pack8(const f32x16& x, int s) { u32x4 p; p[0] = cvtpk(x[8 * s], x[8 * s + 1]); p[1] = cvtpk(x[8 * s + 2], x[8 * s + 3]); p[2] = cvtpk(x[8 * s + 4], x[8 * s + 5]); p[3] = cvtpk(x[8 * s + 6], x[8 * s + 7]); return __builtin_bit_cast(bf16x8, p); }
#define DPP_F(v, ctrl) __builtin_bit_cast(float, __builtin_amdgcn_update_dpp(0, __builtin_bit_cast(int, (v)), (ctrl), 0xf, 0xf, true))
#define MFMA32(a, b, c) __builtin_amdgcn_mfma_f32_32x32x16_bf16((a), (b), (c), 0, 0, 0)

struct EpiSwiglu {
    static constexpr bool PERM = true, AFTER_DRAIN = false;
    bf16* O; const float* ss;
    __device__ __forceinline__ void operator()(const pg8::f32x4 (&acc)[2][2][4][2], const pg8::Unit& u, int wr, int wc, int fr, int fq) const {
        const int col0 = u.pn * 128 + wc * 32 + 8 * fq, row0 = u.pm * 256 + wr * 64 + fr;
        float rsv[2][4];
#pragma unroll
        for (int ai = 0; ai < 2; ++ai)
#pragma unroll
            for (int m = 0; m < 4; ++m) rsv[ai][m] = ss[row0 + ai * 128 + m * 16];
#pragma unroll
        for (int ai = 0; ai < 2; ++ai)
#pragma unroll
            for (int m = 0; m < 4; ++m) {
                const int row = row0 + ai * 128 + m * 16;
                const float rs = rsqrtf(rsv[ai][m] * (1.f / DM) + EPS), c1 = -rs * LOG2E, rs2 = rs * rs;
                u32x4 w;
#pragma unroll
                for (int n = 0; n < 2; ++n) {
                    const pg8::f32x4 g = acc[ai][0][m][n], up = acc[ai][1][m][n];
                    float o4[4];
#pragma unroll
                    for (int k = 0; k < 4; ++k) o4[k] = (g[k] * up[k]) * (rs2 * __builtin_amdgcn_rcpf(1.f + __builtin_amdgcn_exp2f(g[k] * c1)));
                    w[2 * n] = cvtpk(o4[0], o4[1]); w[2 * n + 1] = cvtpk(o4[2], o4[3]);
                }
                *(u32x4*)(O + (size_t)row * FF + col0) = w;
            }
    }
};
struct EpiResid {
    static constexpr bool PERM = true, AFTER_DRAIN = false;
    const float* R; float* X; bf16* XB; float* ssout; float alpha;
    __device__ __forceinline__ void operator()(const pg8::f32x4 (&acc)[2][2][4][2], const pg8::Unit& u, int wr, int wc, int fr, int fq) const {
        const int row0 = u.pm * 256 + wr * 64 + fr, colb = u.pn * 256 + wc * 32 + 8 * fq;
#pragma unroll
        for (int ai = 0; ai < 2; ++ai) {
            pg8::f32x4 rv[4][2][2];
#pragma unroll
            for (int m = 0; m < 4; ++m)
#pragma unroll
                for (int bj = 0; bj < 2; ++bj) { const size_t off = (size_t)(row0 + ai * 128 + m * 16) * DM + colb + bj * 128;
                    rv[m][bj][0] = *(const pg8::f32x4*)(R + off); rv[m][bj][1] = *(const pg8::f32x4*)(R + off + 4); }
#pragma unroll
            for (int m = 0; m < 4; ++m) {
                const int row = row0 + ai * 128 + m * 16;
                float sq = 0.f;
#pragma unroll
                for (int bj = 0; bj < 2; ++bj) {
                    const size_t off = (size_t)row * DM + colb + bj * 128;
                    const pg8::f32x4 v0 = rv[m][bj][0] + acc[ai][bj][m][0] * alpha, v1 = rv[m][bj][1] + acc[ai][bj][m][1] * alpha;
                    *(pg8::f32x4*)(X + off) = v0; *(pg8::f32x4*)(X + off + 4) = v1;
                    u32x4 w; w[0] = cvtpk(v0[0], v0[1]); w[1] = cvtpk(v0[2], v0[3]); w[2] = cvtpk(v1[0], v1[1]); w[3] = cvtpk(v1[2], v1[3]);
                    *(u32x4*)(XB + off) = w;
                    sq += (v0[0] * v0[0] + v0[1] * v0[1]) + (v0[2] * v0[2] + v0[3] * v0[3]) + (v1[0] * v1[0] + v1[1] * v1[1]) + (v1[2] * v1[2] + v1[3] * v1[3]);
                }
                sq += __shfl_xor(sq, 16); sq += __shfl_xor(sq, 32);
                if (fq == 0) atomicAdd(ssout + row, sq);
            }
        }
    }
};
struct EpiProj {
    static constexpr bool PERM = true, AFTER_DRAIN = false;
    bf16* P; bf16* GA; const float* ss;
    __device__ __forceinline__ void operator()(const pg8::f32x4 (&acc)[2][2][4][2], const pg8::Unit& u, int wr, int wc, int fr, int fq) const {
        if (u.pn < 8) {
            bf16* qb_ = P + (size_t)(u.pn >> 2) * TOK * 1024 + (u.pn & 3) * 256 + 64 * wc + 8 * fq;
            const int rowq = u.pm * 256 + wr * 64 + fr;
            float rsq_[2][4];
#pragma unroll
            for (int ai = 0; ai < 2; ++ai)
#pragma unroll
                for (int m = 0; m < 4; ++m) rsq_[ai][m] = ss[rowq + ai * 128 + m * 16];
#pragma unroll
            for (int ai = 0; ai < 2; ++ai)
#pragma unroll
                for (int m = 0; m < 4; ++m) {
                    const int row = rowq + ai * 128 + m * 16;
                    const float rs = rsqrtf(rsq_[ai][m] * (1.f / DM) + EPS);
                    const pg8::f32x4 a0 = acc[ai][0][m][0] * rs, a1 = acc[ai][0][m][1] * rs, b0 = acc[ai][1][m][0] * rs, b1 = acc[ai][1][m][1] * rs;
                    float sq = (a0[0] * a0[0] + a0[1] * a0[1]) + (a0[2] * a0[2] + a0[3] * a0[3]) + (a1[0] * a1[0] + a1[1] * a1[1]) + (a1[2] * a1[2] + a1[3] * a1[3])
                             + (b0[0] * b0[0] + b0[1] * b0[1]) + (b0[2] * b0[2] + b0[3] * b0[3]) + (b1[0] * b1[0] + b1[1] * b1[1]) + (b1[2] * b1[2] + b1[3] * b1[3]);
                    sq += __shfl_xor(sq, 16); sq += __shfl_xor(sq, 32);
                    const float rn = rsqrtf(sq * (1.f / 64.f) + EPS);
                    u32x4 w0, w1;
                    w0[0] = cvtpk(a0[0] * rn, a0[1] * rn); w0[1] = cvtpk(a0[2] * rn, a0[3] * rn); w0[2] = cvtpk(a1[0] * rn, a1[1] * rn); w0[3] = cvtpk(a1[2] * rn, a1[3] * rn);
                    w1[0] = cvtpk(b0[0] * rn, b0[1] * rn); w1[1] = cvtpk(b0[2] * rn, b0[3] * rn); w1[2] = cvtpk(b1[0] * rn, b1[1] * rn); w1[3] = cvtpk(b1[2] * rn, b1[3] * rn);
                    *(u32x4*)(qb_ + (size_t)row * 1024) = w0; *(u32x4*)(qb_ + (size_t)row * 1024 + 32) = w1;
                }
            return;
        }
        const bool gate = u.pn >= 28;
        bf16* base; int ld, colt;
        if (!gate) { base = P + (size_t)(u.pn >> 2) * TOK * 1024; ld = 1024; colt = (u.pn & 3) * 256; }
        else { const int g = u.pn - 28; base = GA + (size_t)(g >> 3) * TOK * 2048; ld = 2048; colt = (g & 7) * 256; }
        colt += wc * 32 + 8 * fq;
        const int grp = u.pn >> 2;
        const int actm = (gate || grp == 4) ? 1 : ((grp == 3 || grp == 6) ? 2 : 0);
        const int row0 = u.pm * 256 + wr * 64 + fr;
        float rsv[2][4];
#pragma unroll
        for (int ai = 0; ai < 2; ++ai)
#pragma unroll
            for (int m = 0; m < 4; ++m) rsv[ai][m] = ss[row0 + ai * 128 + m * 16];
#pragma unroll
        for (int ai = 0; ai < 2; ++ai)
#pragma unroll
            for (int m = 0; m < 4; ++m) {
                const int row = row0 + ai * 128 + m * 16;
                const float rs = rsqrtf(rsv[ai][m] * (1.f / DM) + EPS);
#pragma unroll
                for (int bj = 0; bj < 2; ++bj) {
                    pg8::f32x4 v0 = acc[ai][bj][m][0], v1 = acc[ai][bj][m][1];
                    if (actm == 0) { v0 = v0 * rs; v1 = v1 * rs; }
                    else {
                        const float c1 = -rs * LOG2E, sc = (actm == 2) ? rs : 0.f;
#pragma unroll
                        for (int i = 0; i < 4; ++i) {
                            const float s0 = __builtin_amdgcn_rcpf(1.f + __builtin_amdgcn_exp2f(v0[i] * c1)), s1 = __builtin_amdgcn_rcpf(1.f + __builtin_amdgcn_exp2f(v1[i] * c1));
                            v0[i] = (actm == 2) ? v0[i] * sc * s0 : s0; v1[i] = (actm == 2) ? v1[i] * sc * s1 : s1; }
                    }
                    u32x4 w; w[0] = cvtpk(v0[0], v0[1]); w[1] = cvtpk(v0[2], v0[3]); w[2] = cvtpk(v1[0], v1[1]); w[3] = cvtpk(v1[2], v1[3]);
                    *(u32x4*)(base + (size_t)row * ld + colt + bj * 128) = w;
                }
            }
    }
};
template <bool FIRST> struct EpiMerge {
    static constexpr bool PERM = true, AFTER_DRAIN = false;
    const bf16* G; bf16* Mg;
    __device__ __forceinline__ void operator()(const pg8::f32x4 (&acc)[2][2][4][2], const pg8::Unit& u, int wr, int wc, int fr, int fq) const {
        const int row0 = u.pm * 256 + wr * 64 + fr, colb = u.pn * 256 + wc * 32 + 8 * fq;
#pragma unroll
        for (int ai = 0; ai < 2; ++ai) {
            u32x4 gv[4][2], pv[4][2];
#pragma unroll
            for (int m = 0; m < 4; ++m)
#pragma unroll
                for (int bj = 0; bj < 2; ++bj) { const size_t off = (size_t)(row0 + ai * 128 + m * 16) * DM + colb + bj * 128;
                    gv[m][bj] = *(const u32x4*)(G + off); if (!FIRST) pv[m][bj] = *(const u32x4*)(Mg + off); else pv[m][bj] = (u32x4){0u, 0u, 0u, 0u}; }
#pragma unroll
            for (int m = 0; m < 4; ++m)
#pragma unroll
                for (int bj = 0; bj < 2; ++bj) {
                    const size_t off = (size_t)(row0 + ai * 128 + m * 16) * DM + colb + bj * 128;
                    const u32x4 gw = gv[m][bj];
                    pg8::f32x4 v0 = acc[ai][bj][m][0], v1 = acc[ai][bj][m][1];
                    v0[0] *= bflo(gw[0]); v0[1] *= bfhi(gw[0]); v0[2] *= bflo(gw[1]); v0[3] *= bfhi(gw[1]);
                    v1[0] *= bflo(gw[2]); v1[1] *= bfhi(gw[2]); v1[2] *= bflo(gw[3]); v1[3] *= bfhi(gw[3]);
                    if (!FIRST) { const u32x4 pw = pv[m][bj];
                        v0[0] += bflo(pw[0]); v0[1] += bfhi(pw[0]); v0[2] += bflo(pw[1]); v0[3] += bfhi(pw[1]);
                        v1[0] += bflo(pw[2]); v1[1] += bfhi(pw[2]); v1[2] += bflo(pw[3]); v1[3] += bfhi(pw[3]); }
                    u32x4 w; w[0] = cvtpk(v0[0], v0[1]); w[1] = cvtpk(v0[2], v0[3]); w[2] = cvtpk(v1[0], v1[1]); w[3] = cvtpk(v1[2], v1[3]);
                    *(u32x4*)(Mg + off) = w;
                }
        }
    }
};
struct MergeOrder {
    pg8::StaticOrder so; int nt;
    __device__ __forceinline__ void init(int G_, int c_) { so.init(TOK, DM, G_, c_); nt = (so.nwg > c_) ? (so.nwg - c_ + G_ - 1) / G_ : 0; }
    __device__ __forceinline__ bool next(int i, pg8::Unit& u) const {
        if (i >= 2 * nt) return false;
        const bool second = i >= nt;
        if (!so.next(second ? i - nt : i, u)) return false;
        if (second) { u.pm += TOK / 256; u.pn += DM / 256; }
        return true;
    }
    __device__ __forceinline__ void a_ready(const pg8::Unit&) const {}
    __device__ __forceinline__ void done(const pg8::Unit&) const {}
};
struct EpiMerge2 {
    static constexpr bool PERM = true, AFTER_DRAIN = false;
    const bf16* GA_; const bf16* GB_; bf16* Mg;
    __device__ __forceinline__ void operator()(const pg8::f32x4 (&acc)[2][2][4][2], const pg8::Unit& u, int wr, int wc, int fr, int fq) const {
        const bool second = u.pm >= TOK / 256;
        const int pm = second ? u.pm - TOK / 256 : u.pm, pn = second ? u.pn - DM / 256 : u.pn;
        const bf16* G = second ? GB_ : GA_;
        const int row0 = pm * 256 + wr * 64 + fr, colb = pn * 256 + wc * 32 + 8 * fq;
#pragma unroll
        for (int ai = 0; ai < 2; ++ai) {
            u32x4 gv[4][2], pv[4][2];
#pragma unroll
            for (int m = 0; m < 4; ++m)
#pragma unroll
                for (int bj = 0; bj < 2; ++bj) { const size_t off = (size_t)(row0 + ai * 128 + m * 16) * DM + colb + bj * 128;
                    gv[m][bj] = *(const u32x4*)(G + off); pv[m][bj] = (u32x4){0u, 0u, 0u, 0u}; if (second) pv[m][bj] = *(const u32x4*)(Mg + off); }
#pragma unroll
            for (int m = 0; m < 4; ++m)
#pragma unroll
                for (int bj = 0; bj < 2; ++bj) {
                    const size_t off = (size_t)(row0 + ai * 128 + m * 16) * DM + colb + bj * 128;
                    const u32x4 gw = gv[m][bj], pw = pv[m][bj];
                    pg8::f32x4 v0 = acc[ai][bj][m][0], v1 = acc[ai][bj][m][1];
                    v0[0] = v0[0] * bflo(gw[0]) + bflo(pw[0]); v0[1] = v0[1] * bfhi(gw[0]) + bfhi(pw[0]); v0[2] = v0[2] * bflo(gw[1]) + bflo(pw[1]); v0[3] = v0[3] * bfhi(gw[1]) + bfhi(pw[1]);
                    v1[0] = v1[0] * bflo(gw[2]) + bflo(pw[2]); v1[1] = v1[1] * bfhi(gw[2]) + bfhi(pw[2]); v1[2] = v1[2] * bflo(gw[3]) + bflo(pw[3]); v1[3] = v1[3] * bfhi(gw[3]) + bfhi(pw[3]);
                    u32x4 w; w[0] = cvtpk(v0[0], v0[1]); w[1] = cvtpk(v0[2], v0[3]); w[2] = cvtpk(v1[0], v1[1]); w[3] = cvtpk(v1[2], v1[3]);
                    *(u32x4*)(Mg + off) = w;
                }
        }
    }
};
struct EpiPle {
    static constexpr bool PERM = true, AFTER_DRAIN = false;
    bf16* O; float* ssout;
    __device__ __forceinline__ void operator()(const pg8::f32x4 (&acc)[2][2][4][2], const pg8::Unit& u, int wr, int wc, int fr, int fq) const {
#pragma unroll
        for (int ai = 0; ai < 2; ++ai)
#pragma unroll
            for (int m = 0; m < 4; ++m) {
                const int row = u.pm * 256 + ai * 128 + wr * 64 + m * 16 + fr;
                float sq = 0.f;
#pragma unroll
                for (int bj = 0; bj < 2; ++bj) {
                    const size_t off = (size_t)row * DM + u.pn * 256 + bj * 128 + wc * 32 + 8 * fq;
                    const pg8::f32x4 v0 = acc[ai][bj][m][0], v1 = acc[ai][bj][m][1];
                    u32x4 w; w[0] = cvtpk(v0[0], v0[1]); w[1] = cvtpk(v0[2], v0[3]); w[2] = cvtpk(v1[0], v1[1]); w[3] = cvtpk(v1[2], v1[3]);
                    *(u32x4*)(O + off) = w;
                    sq += (v0[0] * v0[0] + v0[1] * v0[1]) + (v0[2] * v0[2] + v0[3] * v0[3]) + (v1[0] * v1[0] + v1[1] * v1[1]) + (v1[2] * v1[2] + v1[3] * v1[3]);
                }
                sq += __shfl_xor(sq, 16); sq += __shfl_xor(sq, 32);
                if (fq == 0) atomicAdd(ssout + row, sq);
            }
    }
};
struct EpiFinal {
    static constexpr bool PERM = true, AFTER_DRAIN = false;
    float* X; const bf16* PLE; const float* ss4; const float* ssp; const float* gpost;
    __device__ __forceinline__ void operator()(const pg8::f32x4 (&acc)[2][2][4][2], const pg8::Unit& u, int wr, int wc, int fr, int fq) const {
        const int row0 = u.pm * 256 + wr * 64 + fr, colb = u.pn * 256 + wc * 32 + 8 * fq;
        float s4[2][4], sp[2][4]; pg8::f32x4 gp[2][2];
#pragma unroll
        for (int ai = 0; ai < 2; ++ai)
#pragma unroll
            for (int m = 0; m < 4; ++m) { s4[ai][m] = ss4[row0 + ai * 128 + m * 16]; sp[ai][m] = ssp[row0 + ai * 128 + m * 16]; }
#pragma unroll
        for (int bj = 0; bj < 2; ++bj) { gp[bj][0] = *(const pg8::f32x4*)(gpost + colb + bj * 128); gp[bj][1] = *(const pg8::f32x4*)(gpost + colb + bj * 128 + 4); }
#pragma unroll
        for (int ai = 0; ai < 2; ++ai)
#pragma unroll
            for (int mp = 0; mp < 2; ++mp) {
                pg8::f32x4 xv[2][2][2]; u32x4 pl[2][2];
#pragma unroll
                for (int mm = 0; mm < 2; ++mm)
#pragma unroll
                    for (int bj = 0; bj < 2; ++bj) { const size_t off = (size_t)(row0 + ai * 128 + (2 * mp + mm) * 16) * DM + colb + bj * 128;
                        xv[mm][bj][0] = *(const pg8::f32x4*)(X + off); xv[mm][bj][1] = *(const pg8::f32x4*)(X + off + 4); pl[mm][bj] = *(const u32x4*)(PLE + off); }
#pragma unroll
                for (int mm = 0; mm < 2; ++mm) {
                    const int m = 2 * mp + mm;
                    const float rs = rsqrtf(s4[ai][m] * (1.f / DM) + EPS), rp = rsqrtf(sp[ai][m] * (1.f / DM) + EPS);
#pragma unroll
                    for (int bj = 0; bj < 2; ++bj) {
                        const size_t off = (size_t)(row0 + ai * 128 + m * 16) * DM + colb + bj * 128;
                        const u32x4 pw = pl[mm][bj];
                        const pg8::f32x4 g0 = gp[bj][0], g1 = gp[bj][1];
                        pg8::f32x4 x0 = xv[mm][bj][0], x1 = xv[mm][bj][1];
                        const pg8::f32x4 a0 = acc[ai][bj][m][0] * rs, a1 = acc[ai][bj][m][1] * rs;
                        x0[0] += sigm(a0[0]) * (bflo(pw[0]) * rp * g0[0]); x0[1] += sigm(a0[1]) * (bfhi(pw[0]) * rp * g0[1]);
                        x0[2] += sigm(a0[2]) * (bflo(pw[1]) * rp * g0[2]); x0[3] += sigm(a0[3]) * (bfhi(pw[1]) * rp * g0[3]);
                        x1[0] += sigm(a1[0]) * (bflo(pw[2]) * rp * g1[0]); x1[1] += sigm(a1[1]) * (bfhi(pw[2]) * rp * g1[1]);
                        x1[2] += sigm(a1[2]) * (bflo(pw[3]) * rp * g1[2]); x1[3] += sigm(a1[3]) * (bfhi(pw[3]) * rp * g1[3]);
                        *(pg8::f32x4*)(X + off) = x0; *(pg8::f32x4*)(X + off + 4) = x1;
                    }
                }
            }
    }
};

__device__ __forceinline__ float wave_sum(float v) {
#pragma unroll
    for (int o = 1; o < 64; o <<= 1) v += __shfl_xor(v, o);
    return v;
}
__device__ __forceinline__ void transpose_item(const float* __restrict__ W, int K, int N, const float* __restrict__ gain, bf16* WT, int mode, ldsp scr, int item, int lane) {
    const int nblk = N / 32, kb = item / nblk, nb = item % nblk, k0 = 64 * kb, n0 = 32 * nb;
    int r0;
    if (mode == 0) r0 = n0;
    else if (mode == 3) r0 = (n0 < 2048) ? ((n0 & ~255) + ((n0 >> 5) & 1) * 128 + ((n0 >> 6) & 3) * 32) : n0;
    else r0 = (n0 >> 7) * 256 + (mode == 2 ? 128 : 0) + (n0 & 127);
    float tv[32];
#pragma unroll
    for (int i = 0; i < 32; ++i) tv[i] = __builtin_nontemporal_load(&W[(size_t)(k0 + 2 * i + (lane >> 5)) * N + n0 + (lane & 31)]);
#pragma unroll
    for (int i = 0; i < 32; ++i) { const int kk = 2 * i + (lane >> 5); float v = tv[i]; if (gain) v *= gain[k0 + kk]; lds_st<float>(scr + 4 * (kk * 33 + (lane & 31)), v); }
    asm volatile("s_waitcnt lgkmcnt(0)" ::: "memory");
    const int c = lane & 7;
#pragma unroll
    for (int j = 0; j < 4; ++j) { const int n = (lane >> 3) + 8 * j; ldsp s = scr + 4 * ((8 * c) * 33 + n);
        u32x4 o; o[0] = cvtpk(lds_ld<float>(s), lds_ld<float>(s + 132)); o[1] = cvtpk(lds_ld<float>(s + 264), lds_ld<float>(s + 396));
        o[2] = cvtpk(lds_ld<float>(s + 528), lds_ld<float>(s + 660)); o[3] = cvtpk(lds_ld<float>(s + 792), lds_ld<float>(s + 924));
        *(u32x4*)(WT + (size_t)(r0 + n) * K + k0 + 8 * c) = o; }
    asm volatile("s_waitcnt lgkmcnt(0)" ::: "memory");
}
#define RLX_AGENT __ATOMIC_RELAXED, __HIP_MEMORY_SCOPE_AGENT
#define XB_TMO      128
#define XB_XCNT(j)  (256  + 64 * (j))
#define XB_XSUB(j)  (1280 + 64 * (j))
#define XB_XGEN(j)  (2304 + 64 * (j))
#define XB_TOP      3328
#define XB_TOPGEN   3392
#define XCD_BAR_WORDS 3456
#define XB_SPIN_CAP (1u << 18)

__device__ __forceinline__ unsigned xb_ld(unsigned* p)              { return __hip_atomic_load(p, __ATOMIC_RELAXED, __HIP_MEMORY_SCOPE_AGENT); }
__device__ __forceinline__ unsigned xb_add(unsigned* p, unsigned v) { return __hip_atomic_fetch_add(p, v, __ATOMIC_RELAXED, __HIP_MEMORY_SCOPE_AGENT); }
__device__ __forceinline__ unsigned xb_xcc_id() { return (unsigned)__builtin_amdgcn_s_getreg((3 << 11) | 20) & 0xFu; }
#define XB_SPIN(cond, bar) do { unsigned _sp = 0; while (cond) { __builtin_amdgcn_s_sleep(1); \
    if ((++_sp & 255u) == 0u) { if (xb_ld(&(bar)[XB_TMO])) break; if (_sp > XB_SPIN_CAP) { atomicAdd(&(bar)[XB_TMO], 1u); break; } } } } while (0)

struct XcdBarrier {
    unsigned* bar; unsigned x;
    volatile LAS unsigned* st;
};

__device__ __forceinline__ XcdBarrier xcd_barrier_post(unsigned* bar, volatile LAS unsigned* st) {
    XcdBarrier b; b.bar = bar; b.x = xb_xcc_id(); b.st = st;
    if (threadIdx.x == 0) (void)xb_add(&bar[XB_XCNT(b.x)], 1u);
    return b;
}
__device__ __forceinline__ void xcd_barrier_complete(unsigned* bar, unsigned x, unsigned& nloc, unsigned& nx) {
    const unsigned G = gridDim.x * gridDim.y * gridDim.z;
    unsigned sum, cnt, mine, sp = 0u;
    for (;;) {
        sum = 0u; cnt = 0u; mine = 0u;
#pragma unroll
        for (unsigned j = 0; j < 16; ++j) { const unsigned c = xb_ld(&bar[XB_XCNT(j)]); sum += c; cnt += (c > 0u) ? 1u : 0u; mine = (j == x) ? c : mine; }
        if (sum == G) break;
        __builtin_amdgcn_s_sleep(1);
        if ((++sp & 255u) == 0u) { if (xb_ld(&bar[XB_TMO])) break; if (sp > XB_SPIN_CAP) { atomicAdd(&bar[XB_TMO], 1u); break; } }
    }
    nloc = mine > 0u ? mine : 1u; nx = cnt > 0u ? cnt : 1u;
}

__device__ __forceinline__ void xcd_barrier(const XcdBarrier& b) {
    asm volatile("s_waitcnt vmcnt(0)" ::: "memory");
    __syncthreads();
    if (threadIdx.x == 0) {
        unsigned* bar = b.bar;
        __builtin_amdgcn_s_waitcnt(0);
        unsigned nloc = b.st[0], nx = b.st[1];
        if (nloc == 0u) { xcd_barrier_complete(bar, b.x, nloc, nx); b.st[0] = nloc; b.st[1] = nx; }
        const unsigned old = xb_add(&bar[XB_XSUB(b.x)], 1u);
        const unsigned gen = old / nloc;
        if (old + 1u == (gen + 1u) * nloc) {
            __builtin_amdgcn_fence(__ATOMIC_RELEASE, "agent");
            asm volatile("s_waitcnt vmcnt(0)" ::: "memory");
            const unsigned og = xb_add(&bar[XB_TOP], 1u);
            const unsigned tg = og / nx;
            if (og + 1u == (tg + 1u) * nx) xb_add(&bar[XB_TOPGEN], 1u);
            else XB_SPIN(xb_ld(&bar[XB_TOPGEN]) == tg, bar);
            __builtin_amdgcn_fence(__ATOMIC_ACQUIRE, "agent");
            xb_add(&bar[XB_XGEN(b.x)], 1u);
            asm volatile("s_waitcnt vmcnt(0)" ::: "memory");
        } else {
            XB_SPIN(xb_ld(&bar[XB_XGEN(b.x)]) == gen, bar);
            __builtin_amdgcn_fence(__ATOMIC_ACQUIRE, "agent");
            asm volatile("s_waitcnt vmcnt(0)" ::: "memory");
        }
    }
    __syncthreads();
}

constexpr int A_KP = 144, A_KT = 64 * A_KP, A_VP = 320, A_VT = 64 * A_VP, A_STAGE = 2 * A_KT + A_VT;
constexpr int A_TAB = 131072, A_WSF = A_TAB + 512, A_QSLOT = A_WSF + 1024;
constexpr int LDS_BYTES = 147456;
static_assert(2 * A_STAGE <= 131072 && A_QSLOT + 64 <= LDS_BYTES, "attention LDS map");

__device__ __forceinline__ void attn_unit(ldsp L, int bh, int qb, const bf16* __restrict__ dq, const bf16* __restrict__ dk, const bf16* __restrict__ dv, bf16* __restrict__ ya,
                                          const float* __restrict__ qn, const float* __restrict__ kn, const float* __restrict__ relb, const float* __restrict__ subln, float lam) {
    const int tid = threadIdx.x, lane = tid & 63, r32 = lane & 31, hi = lane >> 5, w = __builtin_amdgcn_readfirstlane(tid >> 6), j = w >> 2, qs = w & 3;
    const int b = bh >> 3, h = bh & 7, q0 = qb * 128, qrow0 = q0 + 32 * qs;
    const size_t tok0 = (size_t)b * SEQ;
    if (tid < 128) { const int d = tid; int bk = d;
        if (d >= 16) { bk = 16 + (int)(logf((float)d / 16.f) / 2.0794415416798357f * 16.f); bk = bk > 31 ? 31 : bk; }
        lds_st<float>(L + A_TAB + 4 * d, (relb[bk * 8 + h] - relb[31 * 8 + h]) * LOG2E); }
    const int kr = tid >> 3, c8 = tid & 7;
    const bf16* gk = dk + (tok0 + kr) * 1024 + h * 128 + 8 * c8;
    const bf16* gv = dv + (tok0 + kr) * 1024 + h * 128 + 8 * c8;
    u32x4 k0r = *(const u32x4*)gk, k1r = *(const u32x4*)(gk + 64), v0r = *(const u32x4*)gv, v1r = *(const u32x4*)(gv + 64);
    bf16x8 qr[4];
    { const bf16* qp = dq + (tok0 + qrow0 + r32) * 1024 + h * 128 + j * 64 + hi * 8;
      u32x4 raw[4];
#pragma unroll
      for (int d0 = 0; d0 < 4; ++d0) raw[d0] = *(const u32x4*)(qp + 16 * d0);
      const float rs = 0.125f * LOG2E;
#pragma unroll
      for (int d0 = 0; d0 < 4; ++d0) { u32x4 p;
#pragma unroll
          for (int i = 0; i < 4; ++i) { const int d = 16 * d0 + 8 * hi + 2 * i;
              p[i] = cvtpk(bflo(raw[d0][i]) * rs * qn[d] * kn[d], bfhi(raw[d0][i]) * rs * qn[d + 1] * kn[d + 1]); }
          qr[d0] = __builtin_bit_cast(bf16x8, p); } }
#define A_LOAD(t) do { const size_t o_ = (size_t)(t) * 64 * 1024; k0r = *(const u32x4*)(gk + o_); k1r = *(const u32x4*)(gk + o_ + 64); v0r = *(const u32x4*)(gv + o_); v1r = *(const u32x4*)(gv + o_ + 64); } while (0)
#define A_STORE(buf) do { ldsp s_ = L + (buf) * A_STAGE; lds_st<u32x4>(s_ + kr * A_KP + c8 * 16, k0r); lds_st<u32x4>(s_ + A_KT + kr * A_KP + c8 * 16, k1r); \
        lds_st<u32x4>(s_ + 2 * A_KT + kr * A_VP + c8 * 16, v0r); lds_st<u32x4>(s_ + 2 * A_KT + kr * A_VP + 128 + c8 * 16, v1r); } while (0)
    const int NT = 2 * qb + 2;
    A_STORE(0);
    A_LOAD(1);
    __syncthreads();
    f32x16 o[4]; o[0] = f32x16{}; o[1] = f32x16{}; o[2] = f32x16{}; o[3] = f32x16{};
    f32x16 lacc = f32x16{};
    const bf16x8 ones = (bf16x8){0x3F80, 0x3F80, 0x3F80, 0x3F80, 0x3F80, 0x3F80, 0x3F80, 0x3F80};
    const ldsp wsf = L + A_WSF + w * 128;
    const int qpos = qrow0 + r32;
    for (int t = 0; t < NT; ++t) {
        if (t + 1 < NT) A_STORE((t + 1) & 1);
        if (t + 2 < NT) A_LOAD(t + 2);
        const int kb = 64 * t;
        if (kb <= qrow0 + 31) {
            const ldsp Kj = L + (t & 1) * A_STAGE + j * A_KT + r32 * A_KP + hi * 16;
            f32x16 p0 = f32x16{}, p1 = f32x16{};
#pragma unroll
            for (int d0 = 0; d0 < 4; ++d0) { const bf16x8 a0 = lds_ld<bf16x8>(Kj + d0 * 32), a1 = lds_ld<bf16x8>(Kj + 32 * A_KP + d0 * 32);
                p0 = MFMA32(a0, qr[d0], p0); p1 = MFMA32(a1, qr[d0], p1); }
            if (kb + 63 + 128 > qrow0) {
#pragma unroll
                for (int r = 0; r < 16; ++r) { const int d = qpos - (kb + crow(r, hi)), d2 = d - 32;
                    const float b0 = lds_ld<float>(L + A_TAB + 4 * (d < 0 ? 0 : (d > 127 ? 127 : d))), b1 = lds_ld<float>(L + A_TAB + 4 * (d2 < 0 ? 0 : (d2 > 127 ? 127 : d2)));
                    p0[r] = d < 0 ? -1e30f : p0[r] + b0; p1[r] = d2 < 0 ? -1e30f : p1[r] + b1; }
            }
#pragma unroll
            for (int r = 0; r < 16; ++r) { p0[r] = __builtin_amdgcn_exp2f(p0[r]); p1[r] = __builtin_amdgcn_exp2f(p1[r]); }
            bf16x8 pa[4]; pa[0] = pack8(p0, 0); pa[1] = pack8(p0, 1); pa[2] = pack8(p1, 0); pa[3] = pack8(p1, 1);
            lacc = MFMA32(pa[0], ones, lacc); lacc = MFMA32(pa[1], ones, lacc); lacc = MFMA32(pa[2], ones, lacc); lacc = MFMA32(pa[3], ones, lacc);
            const ldsp vbase = L + (t & 1) * A_STAGE + 2 * A_KT + (4 * hi + ((lane & 15) >> 2)) * A_VP + (16 * ((lane >> 4) & 1) + 4 * (lane & 3)) * 2;
#pragma unroll
            for (int s = 0; s < 4; ++s)
#pragma unroll
                for (int vb = 0; vb < 4; ++vb) { const s16x4 lo = tr_ld(vbase + s * 16 * A_VP + vb * 64), hh = tr_ld(vbase + s * 16 * A_VP + 8 * A_VP + vb * 64);
                    o[vb] = MFMA32(pa[s], cat4(lo, hh), o[vb]); }
        }
        __syncthreads();
    }
#undef A_LOAD
#undef A_STORE
#pragma unroll
    for (int g = 0; g < 4; ++g) {
#pragma unroll
        for (int i = 0; i < 4; ++i) { const float inv = __builtin_amdgcn_rcpf(lacc[4 * g + i]);
#pragma unroll
            for (int vb = 0; vb < 4; ++vb) lds_st<float>(L + j * 65536 + ((qs * 32 + 8 * g + 4 * hi + i) * 128 + 32 * vb + r32) * 4, o[vb][4 * g + i] * inv); } }
    __syncthreads();
    { const int row = tid >> 2, qd = tid & 3; const ldsp e0 = L + (row * 128 + 32 * qd) * 4;
      float d[32]; float ssq = 0.f;
#pragma unroll
      for (int i = 0; i < 8; ++i) { const f32x4 a = lds_ld<f32x4>(e0 + 16 * i), c = lds_ld<f32x4>(e0 + 65536 + 16 * i);
#pragma unroll
          for (int k = 0; k < 4; ++k) { const float x = a[k] - lam * c[k]; d[4 * i + k] = x; ssq += x * x; } }
      ssq += DPP_F(ssq, 0xB1); ssq += DPP_F(ssq, 0x4E);
      const float rs = rsqrtf(ssq * (1.f / 128.f) + EPS) * 0.8f;
      bf16* yp = ya + (tok0 + q0 + row) * 1024 + h * 128 + 32 * qd;
#pragma unroll
      for (int i = 0; i < 4; ++i) { u32x4 wv;
#pragma unroll
          for (int k = 0; k < 4; ++k) { const int c = 8 * i + 2 * k; wv[k] = cvtpk(d[c] * rs * subln[32 * qd + c], d[c + 1] * rs * subln[32 * qd + c + 1]); }
          *(u32x4*)(yp + 8 * i) = wv; } }
    __syncthreads();
}

constexpr int H_QP = 272, H_TP = 80, H_VP = 320;
constexpr int H_QT = 0, H_KT = 32 * H_QP, H_KTT = 2 * 32 * H_QP, H_V = H_KTT + 128 * H_TP, H_DEC = H_V + 32 * H_VP, H_O = H_DEC + 512, H_BUF = H_O + 32 * 512;
static_assert(2 * H_BUF <= 131072, "hgrn LDS map");

__device__ __forceinline__ void hgrn_unit(ldsp L, int bh, const bf16* __restrict__ hq, const bf16* __restrict__ hf, const bf16* __restrict__ hv, const bf16* __restrict__ hg, bf16* __restrict__ yb,
                                          const float* __restrict__ lbl, const float* __restrict__ gnorm) {
    const int tid = threadIdx.x, lane = tid & 63, r32 = lane & 31, hi = lane >> 5, w = __builtin_amdgcn_readfirstlane(tid >> 6);
    const int b = bh >> 3, h = bh & 7;
    const size_t tok0 = (size_t)b * SEQ;
    const bool prep = w >= 4;
    const int pt = tid & 255, cpl = lane & 15, tq = lane >> 4, k0 = 2 * (16 * (w & 3) + cpl);
    const float lb0 = sigm(lbl[h * 128 + k0] - lbl[1024 + h * 128 + k0]), lb1 = sigm(lbl[h * 128 + k0 + 1] - lbl[1024 + h * 128 + k0 + 1]);
    const int vrow = pt >> 3, vc8 = pt & 7;
    f32x16 S[4]; S[0] = f32x16{}; S[1] = f32x16{}; S[2] = f32x16{}; S[3] = f32x16{};
    const int vb = w & 3;
    unsigned qw[8], fw[8]; u32x4 v0r = {0u, 0u, 0u, 0u}, v1r = {0u, 0u, 0u, 0u}, g0r = {0u, 0u, 0u, 0u}, g1r = {0u, 0u, 0u, 0u};
#pragma unroll
    for (int i = 0; i < 8; ++i) { qw[i] = 0u; fw[i] = 0u; }
    auto do_load = [&](int c) {
        const size_t base = (tok0 + 32 * c + 8 * tq) * 1024 + h * 128 + k0;
#pragma unroll
        for (int i = 0; i < 8; ++i) { qw[i] = *(const unsigned*)(hq + base + (size_t)i * 1024); fw[i] = *(const unsigned*)(hf + base + (size_t)i * 1024); }
        const bf16* vsrc = hv + (tok0 + 32 * c + vrow) * 1024 + h * 128 + 8 * vc8;
        v0r = *(const u32x4*)vsrc; v1r = *(const u32x4*)(vsrc + 64);
    };
    auto do_loadg = [&](int c) {
        const size_t off = (tok0 + 32 * c + (pt >> 3)) * 1024 + h * 128 + 16 * (pt & 7);
        g0r = *(const u32x4*)(hg + off); g1r = *(const u32x4*)(hg + off + 8);
    };
    auto do_prep = [&](int c) {
        const ldsp B = L + (c & 1) * H_BUF;
        const u32x4 v0 = v0r, v1 = v1r;
        float qt[2][8], kt[2][8];
#pragma unroll
        for (int ch = 0; ch < 2; ++ch) {
            const float lb = ch ? lb1 : lb0;
            float P = 1.f, Pl[8], kk[8];
#pragma unroll
            for (int i = 0; i < 8; ++i) { const float sg = ch ? bfhi(fw[i]) : bflo(fw[i]); const float f = lb + (1.f - lb) * sg; P *= f; Pl[i] = P; kk[i] = (1.f - lb) * (1.f - sg); }
            const float T0 = __shfl(P, cpl), T1 = __shfl(P, 16 + cpl), T2 = __shfl(P, 32 + cpl), T3 = __shfl(P, 48 + cpl);
            const float pre = tq == 0 ? 1.f : (tq == 1 ? T0 : (tq == 2 ? T0 * T1 : T0 * T1 * T2));
            if (tq == 0) lds_st<float>(B + H_DEC + 4 * (k0 + ch), (T0 * T1) * (T2 * T3));
#pragma unroll
            for (int i = 0; i < 8; ++i) { const float Pt = pre * Pl[i]; const float qv = ch ? bfhi(qw[i]) : bflo(qw[i]);
                qt[ch][i] = qv * Pt; kt[ch][i] = kk[i] * __builtin_amdgcn_rcpf(fmaxf(Pt, 1e-30f)); }
        }
#pragma unroll
        for (int i = 0; i < 8; ++i) { lds_st<unsigned>(B + H_QT + (8 * tq + i) * H_QP + k0 * 2, cvtpk(qt[0][i], qt[1][i])); lds_st<unsigned>(B + H_KT + (8 * tq + i) * H_QP + k0 * 2, cvtpk(kt[0][i], kt[1][i])); }
#pragma unroll
        for (int ch = 0; ch < 2; ++ch) { u32x4 t4; t4[0] = cvtpk(kt[ch][0], kt[ch][1]); t4[1] = cvtpk(kt[ch][2], kt[ch][3]); t4[2] = cvtpk(kt[ch][4], kt[ch][5]); t4[3] = cvtpk(kt[ch][6], kt[ch][7]);
            lds_st<u32x4>(B + H_KTT + (k0 + ch) * H_TP + 16 * tq, t4); }
        lds_st<u32x4>(B + H_V + vrow * H_VP + vc8 * 16, v0); lds_st<u32x4>(B + H_V + vrow * H_VP + 128 + vc8 * 16, v1);
    };
    auto do_final = [&](int c) {
        const ldsp Ob = L + (c & 1) * H_BUF + H_O;
        const int t = pt >> 3, v0 = 16 * (pt & 7);
        float ov[16]; float ssq = 0.f;
#pragma unroll
        for (int i = 0; i < 4; ++i) { const f32x4 a = lds_ld<f32x4>(Ob + (t * 128 + v0 + 4 * i) * 4);
#pragma unroll
            for (int k = 0; k < 4; ++k) { ov[4 * i + k] = a[k]; ssq += a[k] * a[k]; } }
        ssq += DPP_F(ssq, 0xB1); ssq += DPP_F(ssq, 0x4E); ssq += DPP_F(ssq, 0x141);
        const float rs = rsqrtf(ssq * (1.f / 128.f) + EPS);
        const size_t off = (tok0 + 32 * c + t) * 1024 + h * 128 + v0;
        const u32x4 g0 = g0r, g1 = g1r;
        u32x4 w0, w1;
#pragma unroll
        for (int k = 0; k < 4; ++k) { const float a = bflo(g0[k]), c2 = bfhi(g0[k]), a1 = bflo(g1[k]), c1 = bfhi(g1[k]);
            w0[k] = cvtpk(ov[2 * k] * rs * gnorm[v0 + 2 * k] * a, ov[2 * k + 1] * rs * gnorm[v0 + 2 * k + 1] * c2);
            w1[k] = cvtpk(ov[8 + 2 * k] * rs * gnorm[v0 + 8 + 2 * k] * a1, ov[8 + 2 * k + 1] * rs * gnorm[v0 + 8 + 2 * k + 1] * c1); }
        *(u32x4*)(yb + off) = w0; *(u32x4*)(yb + off + 8) = w1;
    };
    auto do_mfma = [&](int c) {
        const ldsp B = L + (c & 1) * H_BUF;
        const ldsp Qt = B + H_QT + r32 * H_QP, Kt = B + H_KT + r32 * H_QP;
        f32x16 D = f32x16{};
#pragma unroll
        for (int kk = 0; kk < 8; ++kk) { const bf16x8 a = lds_ld<bf16x8>(Kt + (16 * kk + 8 * hi) * 2), bq = lds_ld<bf16x8>(Qt + (16 * kk + 8 * hi) * 2); D = MFMA32(a, bq, D); }
#pragma unroll
        for (int r = 0; r < 16; ++r) if (crow(r, hi) > r32) D[r] = 0.f;
        const bf16x8 aD0 = pack8(D, 0), aD1 = pack8(D, 1);
        const ldsp vbase = B + H_V + ((lane & 15) >> 2) * H_VP + (32 * vb + 16 * ((lane >> 4) & 1) + 4 * (lane & 3)) * 2;
        f32x16 o = f32x16{};
        { const s16x4 lo = tr_ld(vbase + (4 * hi) * H_VP), hh = tr_ld(vbase + (8 + 4 * hi) * H_VP); o = MFMA32(aD0, cat4(lo, hh), o); }
        { const s16x4 lo = tr_ld(vbase + (16 + 4 * hi) * H_VP), hh = tr_ld(vbase + (24 + 4 * hi) * H_VP); o = MFMA32(aD1, cat4(lo, hh), o); }
#pragma unroll
        for (int kb = 0; kb < 4; ++kb)
#pragma unroll
            for (int s2 = 0; s2 < 2; ++s2) { const u32x2 q1 = lds_ld<u32x2>(Qt + (32 * kb + 16 * s2 + 4 * hi) * 2), q2 = lds_ld<u32x2>(Qt + (32 * kb + 16 * s2 + 8 + 4 * hi) * 2);
                const u32x4 qa = {q1[0], q1[1], q2[0], q2[1]};
                o = MFMA32(__builtin_bit_cast(bf16x8, qa), pack8(S[kb], s2), o); }
        const ldsp Ob = B + H_O;
#pragma unroll
        for (int r = 0; r < 16; ++r) lds_st<float>(Ob + (crow(r, hi) * 128 + 32 * vb + r32) * 4, o[r]);
#pragma unroll
        for (int kb = 0; kb < 4; ++kb) {
#pragma unroll
            for (int s2 = 0; s2 < 2; ++s2) { const bf16x8 ka = lds_ld<bf16x8>(B + H_KTT + (32 * kb + r32) * H_TP + (16 * s2 + 8 * hi) * 2);
                const s16x4 lo = tr_ld(vbase + (16 * s2 + 8 * hi) * H_VP), hh = tr_ld(vbase + (16 * s2 + 8 * hi + 4) * H_VP);
                S[kb] = MFMA32(ka, cat4(lo, hh), S[kb]); }
#pragma unroll
            for (int g = 0; g < 4; ++g) { const f32x4 d4 = lds_ld<f32x4>(B + H_DEC + (32 * kb + 8 * g + 4 * hi) * 4);
#pragma unroll
                for (int i = 0; i < 4; ++i) S[kb][4 * g + i] *= d4[i]; }
        }
    };
    if (prep) { do_load(0); do_prep(0); do_load(1); }
    __syncthreads();
    for (int c = 0; c < 64; ++c) {
        if (prep) {
            if (c + 1 < 64) do_prep(c + 1);
            if (c + 2 < 64) do_load(c + 2);
            if (c > 0) do_final(c - 1);
            do_loadg(c);
        }
        else do_mfma(c);
        __syncthreads();
    }
    if (prep) do_final(63);
    __syncthreads();
}

struct Args { const float* in[29]; float* out; unsigned char* ws; int ph_lo, ph_hi; };
constexpr int N_PHASES = 10;
constexpr size_t WS_BAR = 512 * 1024;
constexpr int LDS_BARST = 133120;

__global__ void __launch_bounds__(512, 2) fwd_megakernel(Args a) {
    extern __shared__ __attribute__((aligned(16))) unsigned char lds_raw[];
    const ldsp L = (ldsp)lds_raw;
    PG8_LAS unsigned char* const LG = (PG8_LAS unsigned char*)lds_raw;
    cg::grid_group grid = cg::this_grid();
    const int tid = threadIdx.x, lane = tid & 63, wave = __builtin_amdgcn_readfirstlane(tid >> 6);
    const int G = gridDim.x, bx = blockIdx.x;
    unsigned char* ws = a.ws;
    float* ctl = (float*)(ws + WS_CTL);
    bf16* Win_t = (bf16*)(ws + WS_WIN); bf16* Wgu_t = (bf16*)(ws + WS_WGU); bf16* Wd_t = (bf16*)(ws + WS_WD);
    bf16* Wa_t = (bf16*)(ws + WS_WA); bf16* Wb_t = (bf16*)(ws + WS_WB); bf16* Wo_t = (bf16*)(ws + WS_WO); bf16* Wpg_t = (bf16*)(ws + WS_WPG); bf16* Wpp_t = (bf16*)(ws + WS_WPP); bf16* PB = (bf16*)(ws + WS_PB);
    bf16* XB = (bf16*)(ws + WS_XB); bf16* YA = XB; bf16* YB = XB + (size_t)TOK * 1024;
    bf16* ACT = (bf16*)(ws + WS_BIG); bf16* PROJ = ACT; bf16* GAB = (bf16*)(ws + WS_BIG + BIG_GA); bf16* MERGED = ACT; bf16* PLE = (bf16*)(ws + WS_BIG + BIG_PLE);
    float* OUT = a.out;
    const int lo = a.ph_lo, hi_ = a.ph_hi;
    if (tid < 4) lds_st<unsigned>(L + LDS_BARST + 4 * tid, 0u);
    __syncthreads();
    XcdBarrier xbar; xbar.bar = (unsigned*)(ws + WS_BAR); xbar.x = 0; xbar.st = nullptr;
    if (hi_ - lo > 1) xbar = xcd_barrier_post((unsigned*)(ws + WS_BAR), (volatile LAS unsigned*)(L + LDS_BARST));
    if (lo < 0) grid.sync();
#define IN(k) (lo <= (k) && (k) < hi_)
#define SEAM(k) do { if (IN(k) && IN((k) + 1)) xcd_barrier(xbar); } while (0)
#define RUN_GEMM(EPI, Aptr, Bptr, N_, K_, Eobj) do { pg8::Gemm g_{(const pg8::bf16_t*)(Aptr), (const pg8::bf16_t*)(Bptr), TOK, (N_), (K_)}; pg8::StaticOrder S_; S_.init(TOK, (N_), G, bx); \
        pg8::gemm_phase<EPI, pg8::StaticOrder, true, true>(LG, g_, S_, Eobj); } while (0)

    if (IN(0)) {
        const int gw = bx * 8 + wave, NGW = G * 8;
        for (int i = bx * 512 + tid; i < C_ZERO_END - C_SS2; i += G * 512) ctl[C_SS2 + i] = 0.f;
        const ldsp scr = L + wave * 16384;
        constexpr int I_GU = (DM / 64) * (FF / 32), I_D = (FF / 64) * (DM / 32), I_IN = (DM / 64) * (NIN / 32);
        for (int it = gw; it < 2 * I_GU + I_D + I_IN; it += NGW) {
            int r = it;
            if (r < I_GU) { transpose_item(a.in[3], DM, FF, a.in[2], Wgu_t, 1, scr, r, lane); continue; } r -= I_GU;
            if (r < I_GU) { transpose_item(a.in[4], DM, FF, a.in[2], Wgu_t, 2, scr, r, lane); continue; } r -= I_GU;
            if (r < I_D) { transpose_item(a.in[5], FF, DM, nullptr, Wd_t, 0, scr, r, lane); continue; } r -= I_D;
            transpose_item(a.in[7], DM, NIN, a.in[6], Win_t, 3, scr, r, lane);
        }
        for (int m = gw; m < TOK; m += NGW) {
            const f32x4* xr = (const f32x4*)(a.in[0] + (size_t)m * DM) + lane;
            f32x4 v[8]; float s = 0.f;
#pragma unroll
            for (int j = 0; j < 8; ++j) { v[j] = __builtin_nontemporal_load(xr + 64 * j); s += (v[j][0] * v[j][0] + v[j][1] * v[j][1]) + (v[j][2] * v[j][2] + v[j][3] * v[j][3]); }
            s = wave_sum(s);
            if (lane == 0) ctl[C_SS1 + m] = s;
            u32x2* o8 = (u32x2*)(XB + (size_t)m * DM) + lane;
#pragma unroll
            for (int j = 0; j < 8; ++j) { u32x2 w2; w2[0] = cvtpk(v[j][0], v[j][1]); w2[1] = cvtpk(v[j][2], v[j][3]); o8[64 * j] = w2; }
        }
    }
    SEAM(0);
    if (IN(1)) { EpiSwiglu E{ACT, ctl + C_SS1}; RUN_GEMM(EpiSwiglu, XB, Wgu_t, 2 * FF, DM, E); }
    SEAM(1);
    if (IN(2)) { EpiResid E{a.in[0], OUT, XB, ctl + C_SS2, 0.5f}; RUN_GEMM(EpiResid, ACT, Wd_t, DM, FF, E); }
    SEAM(2);
    if (IN(3)) { EpiProj E{PROJ, GAB, ctl + C_SS2}; RUN_GEMM(EpiProj, XB, Win_t, NIN, DM, E); }
    SEAM(3);
    if (IN(4)) {
        const size_t PS = (size_t)TOK * 1024;
        if (bx < 64 && G > 64) {
            hgrn_unit(L, bx, PROJ + 3 * PS, PROJ + 4 * PS, PROJ + 5 * PS, PROJ + 6 * PS, YB, a.in[16], a.in[17]);
        } else {
            if (G <= 64) { for (int u = bx; u < 64; u += G) hgrn_unit(L, u, PROJ + 3 * PS, PROJ + 4 * PS, PROJ + 5 * PS, PROJ + 6 * PS, YB, a.in[16], a.in[17]); }
            const int nb0 = (G > 64) ? 64 : 0;
            const int gw = (bx - nb0) * 8 + wave, NGW = (G - nb0) * 8;
            const ldsp scr = L + wave * 16384;
            constexpr int I_A = (1024 / 64) * (DM / 32), I_O = (DM / 64) * (DM / 32), I_PP = (256 / 64) * (DM / 32), I_GU = (DM / 64) * (FF / 32), I_D = (FF / 64) * (DM / 32);
            for (int it = gw; it < 2 * I_A + 2 * I_O + I_PP + 2 * I_GU + I_D; it += NGW) {
                int r = it;
                if (r < I_A) { transpose_item(a.in[18], 1024, DM, nullptr, Wa_t, 0, scr, r, lane); continue; } r -= I_A;
                if (r < I_A) { transpose_item(a.in[19], 1024, DM, nullptr, Wb_t, 0, scr, r, lane); continue; } r -= I_A;
                if (r < I_O) { transpose_item(a.in[20], DM, DM, nullptr, Wo_t, 0, scr, r, lane); continue; } r -= I_O;
                if (r < I_O) { transpose_item(a.in[26], DM, DM, a.in[25], Wpg_t, 0, scr, r, lane); continue; } r -= I_O;
                if (r < I_PP) { transpose_item(a.in[27], 256, DM, nullptr, Wpp_t, 0, scr, r, lane); continue; } r -= I_PP;
                if (r < I_GU) { transpose_item(a.in[22], DM, FF, a.in[21], Wgu_t, 1, scr, r, lane); continue; } r -= I_GU;
                if (r < I_GU) { transpose_item(a.in[23], DM, FF, a.in[21], Wgu_t, 2, scr, r, lane); continue; } r -= I_GU;
                transpose_item(a.in[24], FF, DM, nullptr, Wd_t, 0, scr, r, lane);
            }
            for (int i = (bx - nb0) * 512 + tid; i < TOK * 256 / 8; i += (G - nb0) * 512) {
                const f32x4 p0 = __builtin_nontemporal_load((const f32x4*)(a.in[1] + (size_t)i * 8)), p1 = __builtin_nontemporal_load((const f32x4*)(a.in[1] + (size_t)i * 8 + 4));
                u32x4 w4; w4[0] = cvtpk(p0[0], p0[1]); w4[1] = cvtpk(p0[2], p0[3]); w4[2] = cvtpk(p1[0], p1[1]); w4[3] = cvtpk(p1[2], p1[3]);
                *(u32x4*)(PB + (size_t)i * 8) = w4;
            }
        }
        __syncthreads();
        float lam;
        { float s1 = 0.f, s2 = 0.f;
          for (int i = 0; i < 64; ++i) { s1 += a.in[10][i] * a.in[11][i]; s2 += a.in[12][i] * a.in[13][i]; }
          lam = expf(s1) - expf(s2) + 0.2f; }
        unsigned* queue = (unsigned*)(ctl + C_QUEUE);
        int qx = (int)(xb_xcc_id() & 7u), tries = 0;
        auto pop = [&]() -> unsigned {
            while (tries < 8) { const unsigned i = atomicAdd(queue + 16 * qx, 1u); if (i < 128u) return ((unsigned)qx << 7) | i; qx = (qx + 1) & 7; ++tries; }
            return 0xffffffffu; };
        if (tid == 0) lds_st<unsigned>(L + A_QSLOT, pop());
        __syncthreads();
        for (;;) {
            const unsigned u = lds_ld<unsigned>(L + A_QSLOT);
            if (u == 0xffffffffu) break;
            unsigned nxt = 0u;
            if (tid == 0) nxt = pop();
            attn_unit(L, (int)((u >> 7) + 8u * (u & 7u)), 15 - (int)((u >> 3) & 15u), PROJ, PROJ + PS, PROJ + 2 * PS, YA, a.in[8], a.in[9], a.in[15], a.in[14], lam);
            if (tid == 0) lds_st<unsigned>(L + A_QSLOT, nxt);
            __syncthreads();
        }
    }
    SEAM(4);
    if (IN(5)) {
        static_assert(WS_WB == WS_WA + (size_t)DM * 1024 * 2, "Wa_t and Wb_t are contiguous");
        pg8::Gemm g_{(const pg8::bf16_t*)YA, (const pg8::bf16_t*)Wa_t, 2 * TOK, 2 * DM, 1024}; MergeOrder S_; S_.init(G, bx);
        EpiMerge2 E{GAB, GAB + (size_t)TOK * 2048, MERGED};
        pg8::gemm_phase<EpiMerge2, MergeOrder, true, true>(LG, g_, S_, E);
    }
    SEAM(5);
    if (IN(6)) { EpiResid E{OUT, OUT, XB, ctl + C_SS3, 1.0f}; RUN_GEMM(EpiResid, MERGED, Wo_t, DM, DM, E); }
    SEAM(6);
    if (IN(7)) {
        { EpiSwiglu E{ACT, ctl + C_SS3}; RUN_GEMM(EpiSwiglu, XB, Wgu_t, 2 * FF, DM, E); }
        { int kple = 256; asm volatile("" : "+s"(kple)); EpiPle E{PLE, ctl + C_SSP}; RUN_GEMM(EpiPle, PB, Wpp_t, DM, kple, E); }
    }
    SEAM(7);
    if (IN(8)) { EpiResid E{OUT, OUT, XB, ctl + C_SS4, 0.5f}; RUN_GEMM(EpiResid, ACT, Wd_t, DM, FF, E); }
    SEAM(8);
    if (IN(9)) { EpiFinal E{OUT, PLE, ctl + C_SS4, ctl + C_SSP, a.in[28]}; RUN_GEMM(EpiFinal, XB, Wpg_t, DM, DM, E); }
#undef IN
#undef SEAM
#undef RUN_GEMM
}

#ifndef MK_PER_PHASE
#define MK_PER_PHASE 0
#endif
extern "C" void kernel_launch(void* const* d_in, const int* in_sizes, int n_in, void* d_out, int out_size, void* d_ws, size_t ws_size, hipStream_t stream) {
    static int grid = 0;
    if (grid == 0) {
        if (n_in != 29 || out_size != TOK * DM || ws_size < WS_END) { fprintf(stderr, "kernel_launch: unexpected problem: n_in %d out %d ws %zu (need >= %zu)\n", n_in, out_size, ws_size, (size_t)WS_END); grid = -1; return; }
        int dev = 0, cus = 0, per_cu = 0;
        (void)hipGetDevice(&dev); (void)hipDeviceGetAttribute(&cus, hipDeviceAttributeMultiprocessorCount, dev);
        if (hipFuncSetAttribute((const void*)fwd_megakernel, hipFuncAttributeMaxDynamicSharedMemorySize, LDS_BYTES) != hipSuccess) { fprintf(stderr, "kernel_launch: hipFuncSetAttribute failed\n"); grid = -1; return; }
        if (hipOccupancyMaxActiveBlocksPerMultiprocessor(&per_cu, (const void*)fwd_megakernel, 512, LDS_BYTES) != hipSuccess || per_cu < 1) { fprintf(stderr, "kernel_launch: occupancy query says %d\n", per_cu); per_cu = 1; }
        (void)hipGetLastError();
        grid = cus;
        if (grid <= 0) grid = 256;
    }
    if (grid < 0) return;
    if (hipMemsetAsync((char*)d_ws + WS_BAR, 0, 16384, stream) != hipSuccess) { fprintf(stderr, "kernel_launch: memset failed\n"); return; }
    Args a{};
    for (int i = 0; i < 29; ++i) a.in[i] = (const float*)d_in[i];
    a.out = (float*)d_out; a.ws = (unsigned char*)d_ws;
#if MK_PER_PHASE
    for (int p = 0; p < N_PHASES; ++p) { a.ph_lo = p; a.ph_hi = p + 1; hipLaunchKernelGGL(fwd_megakernel, dim3(grid), dim3(512), LDS_BYTES, stream, a); }
#else
    a.ph_lo = 0; a.ph_hi = N_PHASES;
    void* args[] = {&a};
    hipError_t e = hipLaunchCooperativeKernel((const void*)fwd_megakernel, dim3(grid), dim3(512), args, LDS_BYTES, stream);
    if (e != hipSuccess) fprintf(stderr, "kernel_launch: cooperative launch failed: %s (grid %d)\n", hipGetErrorString(e), grid);
#endif
}
```

```cpp
#include <hip/hip_runtime.h>
#include <hip/hip_cooperative_groups.h>
#include <cstdio>
#include <cstdint>
namespace cg = cooperative_groups;
namespace pg8 {
#define PG8_LAS __attribute__((address_space(3)))
typedef unsigned short bf16_t;
typedef short bf16x8 __attribute__((ext_vector_type(8)));
typedef float f32x4 __attribute__((ext_vector_type(4)));
typedef unsigned u32x4 __attribute__((ext_vector_type(4)));
constexpr int BM = 256, BK = 64, HALF = 128, HTB = HALF * BK * 2  , STAGE_BYTES = 8 * HTB, NXCD = 8, WGM = 2;

__host__ __device__ __forceinline__ int lds_byte(int r, int c) { const int st = (r >> 4) * 2 + (c >> 5), rr = r & 15, cc = c & 31, ob = rr * 64 + cc * 2; return st * 1024 + (ob ^ (((ob >> 9) & 1) << 5)); }
__host__ __device__ __forceinline__ void stage_rc(int b, int& R, int& C) { const int st = b / 1024, sb = b % 1024, swz = sb ^ (((sb >> 9) & 1) << 5); R = (st >> 1) * 16 + swz / 64; C = (st & 1) * 32 + (swz % 64) / 2; }
__host__ __device__ __forceinline__ int perm32(int rho) { const int n = rho >> 4, i = rho & 15; return 8 * (i >> 2) + 4 * n + (i & 3); }

struct Unit { int pm, pn; };
struct Gemm { const bf16_t* A; const bf16_t* Bt; int M, N, K; };

struct StaticOrder {
    int nM, nN, nwg, G, c;
    __host__ __device__ void init(int M, int N, int G_, int c_) { nM = M / BM; nN = N / BM; nwg = nM * nN; G = G_; c = c_; }
    __host__ __device__ bool next(int i, Unit& u) const {
        const long L = (long)i * G + c; if (L >= nwg) return false;
        int wgid = (int)L; { const int q = nwg / NXCD, r = nwg % NXCD, xcd = wgid % NXCD, off = wgid / NXCD; wgid = (xcd < r ? xcd * (q + 1) : r * (q + 1) + (xcd - r) * q) + off; }
        const int nig = WGM * nN, gid = wgid / nig, fm = gid * WGM, gsz = (nM - fm) < WGM ? (nM - fm) : WGM;
        u.pm = fm + ((wgid % nig) % gsz); u.pn = (wgid % nig) / gsz; return true;
    }
    __device__ __forceinline__ void a_ready(const Unit&) const {}
    __device__ __forceinline__ void done(const Unit&) const {}
};

__device__ __forceinline__ unsigned cvt_pk_bf16(float lo, float hi) { unsigned r; asm volatile("v_cvt_pk_bf16_f32 %0, %1, %2" : "=v"(r) : "v"(lo), "v"(hi)); return r; }
typedef float f32x2 __attribute__((ext_vector_type(2)));
template <class Epi, class Sched, bool ALIGN_EPI = false, bool SP2 = false>
__device__ __forceinline__ void gemm_phase(PG8_LAS unsigned char* lds, const Gemm g, const Sched& S, const Epi& E) {
    const int tid = threadIdx.x, wid = __builtin_amdgcn_readfirstlane(tid >> 6), lane = tid & 63, wr = wid >> 2, wc = wid & 3, fr = lane & 15, fq = lane >> 4;
    const int K = g.K, nt = K / BK;
    unsigned voffA[2], voffB[2];
#pragma unroll
    for (int i = 0; i < 2; ++i) { int R, C; stage_rc(tid * 16 + i * 8192, R, C); const int Rb = Epi::PERM ? ((R & ~31) + perm32(R & 31)) : R;
        voffA[i] = (unsigned)(R * K + C) * 2u; voffB[i] = (unsigned)(Rb * K + C) * 2u; }
    const size_t kstep = (size_t)(BK * 2);
    const size_t hstep = (size_t)HALF * K * 2;
    const size_t tstep = 2 * hstep;
    const unsigned ldsw = (unsigned)wid * 1024u;
    const int aoff = lds_byte(wr * 64 + fr, fq * 8), boff = lds_byte(wc * 32 + fr, fq * 8);
#define PG8_SA(b, h) (((b) * 2 + (h)) * HTB)
#define PG8_SB(b, h) ((4 + (b) * 2 + (h)) * HTB)
#define PG8_STAGE(bufoff, gbase, voff) do { _Pragma("unroll") for (int _i = 0; _i < 2; ++_i) \
        __builtin_amdgcn_global_load_lds((const unsigned*)((const char*)(gbase) + (voff)[_i]), (PG8_LAS unsigned*)(lds + (bufoff) + ldsw + _i * 8192), 16, 0, 0); } while (0)
#define PG8_LDA(dst, b, h) do { _Pragma("unroll") for (int m = 0; m < 4; ++m) _Pragma("unroll") for (int k = 0; k < 2; ++k) dst[m][k] = *(const PG8_LAS bf16x8*)(lds + PG8_SA(b, h) + aoff + m * 2048 + k * 1024); } while (0)
#define PG8_LDB(dst, b, h) do { _Pragma("unroll") for (int n = 0; n < 2; ++n) _Pragma("unroll") for (int k = 0; k < 2; ++k) dst[n][k] = *(const PG8_LAS bf16x8*)(lds + PG8_SB(b, h) + boff + n * 2048 + k * 1024); } while (0)
#define PG8_MMA(ai, bj, At, Bt) do { __builtin_amdgcn_s_setprio(1); _Pragma("unroll") for (int m = 0; m < 4; ++m) _Pragma("unroll") for (int n = 0; n < 2; ++n) _Pragma("unroll") for (int k = 0; k < 2; ++k) \
        acc[ai][bj][m][n] = __builtin_amdgcn_mfma_f32_16x16x32_bf16(Bt[n][k], At[m][k], acc[ai][bj][m][n], 0, 0, 0); __builtin_amdgcn_s_setprio(0); } while (0)
#define PG8_WAIT_V(n) asm volatile("s_waitcnt vmcnt(" #n ")" ::: "memory")
#define PG8_WAIT_L(n) asm volatile("s_waitcnt lgkmcnt(" #n ")" ::: "memory")
#define PG8_BAR __builtin_amdgcn_s_barrier()
#define PG8_SCHED __builtin_amdgcn_sched_barrier(0)
    Unit cur, nxt; int ui = 0;
    if (!S.next(0, cur)) return;
    f32x4 acc[2][2][4][2];
#pragma unroll
    for (int a = 0; a < 2; ++a)
#pragma unroll
        for (int b = 0; b < 2; ++b)
#pragma unroll
            for (int m = 0; m < 4; ++m)
#pragma unroll
                for (int n = 0; n < 2; ++n) acc[a][b][m][n] = (f32x4){0.f, 0.f, 0.f, 0.f};
    bf16x8 At[4][2], B0[2][2], B1[2][2];
    const char* cA = (const char*)g.A + (size_t)cur.pm * tstep; const char* cB = (const char*)g.Bt + (size_t)cur.pn * tstep;
    S.a_ready(cur);
    if constexpr (SP2) {
        PG8_STAGE(PG8_SB(0, 0), cB, voffB); PG8_STAGE(PG8_SB(0, 1), cB + hstep, voffB); PG8_STAGE(PG8_SA(0, 0), cA, voffA); PG8_STAGE(PG8_SA(0, 1), cA + hstep, voffA);
        if (wr == 1) PG8_BAR;
        PG8_WAIT_V(2); PG8_BAR;
        PG8_STAGE(PG8_SB(1, 0), cB + kstep, voffB); PG8_STAGE(PG8_SA(1, 0), cA + kstep, voffA); PG8_STAGE(PG8_SB(1, 1), cB + hstep + kstep, voffB);
        PG8_WAIT_V(6); PG8_BAR;
    } else {
        PG8_STAGE(PG8_SB(0, 0), cB, voffB); PG8_STAGE(PG8_SA(0, 0), cA, voffA); PG8_STAGE(PG8_SB(0, 1), cB + hstep, voffB); PG8_STAGE(PG8_SA(0, 1), cA + hstep, voffA);
        if (wr == 1) PG8_BAR;
        PG8_WAIT_V(4); PG8_BAR;
        PG8_STAGE(PG8_SB(1, 0), cB + kstep, voffB); PG8_STAGE(PG8_SA(1, 0), cA + kstep, voffA); PG8_STAGE(PG8_SB(1, 1), cB + hstep + kstep, voffB);
        PG8_WAIT_V(6); PG8_BAR;
    }
    for (;;) {
        const bool has_next = S.next(ui + 1, nxt);
        const char* nA = has_next ? (const char*)g.A + (size_t)nxt.pm * tstep : cA; const char* nB = has_next ? (const char*)g.Bt + (size_t)nxt.pn * tstep : cB;
        for (int t = 0; t < nt; t += 2) {
            const bool last = (t == nt - 2);
            const char* a1 = cA + (size_t)(t + 1) * kstep;
            const char* a2 = last ? nA : cA + (size_t)(t + 2) * kstep; const char* b2 = last ? nB : cB + (size_t)(t + 2) * kstep;
            const char* a3 = a2 + kstep; const char* b3 = b2 + kstep;
            if (last && has_next) S.a_ready(nxt);
            if constexpr (SP2) {
            PG8_LDB(B0, 0, 0); PG8_LDB(B1, 0, 1); PG8_SCHED; PG8_LDA(At, 0, 0); PG8_STAGE(PG8_SA(1, 1), a1 + hstep, voffA);
            PG8_WAIT_V(8); PG8_WAIT_L(0); PG8_BAR; PG8_MMA(0, 0, At, B0); PG8_MMA(0, 1, At, B1); PG8_BAR; PG8_SCHED;
            PG8_LDA(At, 0, 1); PG8_STAGE(PG8_SB(0, 0), b2, voffB); PG8_STAGE(PG8_SB(0, 1), b2 + hstep, voffB); PG8_STAGE(PG8_SA(0, 0), a2, voffA);
            PG8_WAIT_V(8); PG8_WAIT_L(0); PG8_BAR; PG8_MMA(1, 0, At, B0); PG8_MMA(1, 1, At, B1); PG8_BAR; PG8_SCHED;
            PG8_LDB(B0, 1, 0); PG8_LDB(B1, 1, 1); PG8_SCHED; PG8_LDA(At, 1, 0); PG8_STAGE(PG8_SA(0, 1), a2 + hstep, voffA);
            PG8_WAIT_V(8); PG8_WAIT_L(0); PG8_BAR; PG8_MMA(0, 0, At, B0); PG8_MMA(0, 1, At, B1); PG8_BAR; PG8_SCHED;
            PG8_LDA(At, 1, 1); PG8_STAGE(PG8_SB(1, 0), b3, voffB); PG8_STAGE(PG8_SB(1, 1), b3 + hstep, voffB); PG8_STAGE(PG8_SA(1, 0), a3, voffA);
            PG8_WAIT_V(8); PG8_WAIT_L(0); PG8_BAR; PG8_MMA(1, 0, At, B0); PG8_MMA(1, 1, At, B1); PG8_BAR; PG8_SCHED;
            } else {
            PG8_LDB(B0, 0, 0); PG8_SCHED; PG8_LDA(At, 0, 0); PG8_STAGE(PG8_SA(1, 1), a1 + hstep, voffA);
            PG8_WAIT_L(8); PG8_BAR; PG8_WAIT_L(0); PG8_MMA(0, 0, At, B0); PG8_BAR; PG8_SCHED;
            PG8_LDB(B1, 0, 1); PG8_STAGE(PG8_SB(0, 0), b2, voffB);
            PG8_BAR; PG8_WAIT_L(0); PG8_MMA(0, 1, At, B1); PG8_BAR;
            PG8_LDA(At, 0, 1); PG8_STAGE(PG8_SA(0, 0), a2, voffA);
            PG8_BAR; PG8_WAIT_L(0); PG8_MMA(1, 0, At, B0); PG8_BAR; PG8_SCHED;
            PG8_STAGE(PG8_SB(0, 1), b2 + hstep, voffB);
            PG8_WAIT_V(6); PG8_BAR; PG8_MMA(1, 1, At, B1); PG8_BAR;
            PG8_LDB(B0, 1, 0); PG8_SCHED; PG8_LDA(At, 1, 0); PG8_STAGE(PG8_SA(0, 1), a2 + hstep, voffA);
            PG8_WAIT_L(8); PG8_BAR; PG8_WAIT_L(0); PG8_MMA(0, 0, At, B0); PG8_BAR; PG8_SCHED;
            PG8_LDB(B1, 1, 1); PG8_STAGE(PG8_SB(1, 0), b3, voffB);
            PG8_BAR; PG8_WAIT_L(0); PG8_MMA(0, 1, At, B1); PG8_BAR;
            PG8_LDA(At, 1, 1); PG8_STAGE(PG8_SA(1, 0), a3, voffA);
            PG8_BAR; PG8_WAIT_L(0); PG8_MMA(1, 0, At, B0); PG8_BAR; PG8_SCHED;
            PG8_STAGE(PG8_SB(1, 1), b3 + hstep, voffB);
            PG8_WAIT_V(6); PG8_BAR; PG8_MMA(1, 1, At, B1); PG8_BAR;
            }
        }
        if constexpr (ALIGN_EPI) { if (wr == 0) PG8_BAR; }
        if constexpr (!Epi::AFTER_DRAIN) { E(acc, cur, wr, wc, fr, fq); S.done(cur); }
        if (!has_next) break;
#pragma unroll
        for (int a = 0; a < 2; ++a)
#pragma unroll
            for (int b = 0; b < 2; ++b)
#pragma unroll
                for (int m = 0; m < 4; ++m)
#pragma unroll
                    for (int n = 0; n < 2; ++n) acc[a][b][m][n] = (f32x4){0.f, 0.f, 0.f, 0.f};
        cur = nxt; cA = nA; cB = nB; ++ui;
        if constexpr (ALIGN_EPI) { if (wr == 1) PG8_BAR; }
    }
    PG8_WAIT_V(0);
    if constexpr (!ALIGN_EPI) { if (wr == 0) PG8_BAR; }
    PG8_BAR;
    if constexpr (Epi::AFTER_DRAIN) { E.fused(acc, cur, wr, wc, fr, fq, lds, wid, lane); S.done(cur); }
#undef PG8_SA
#undef PG8_SB
#undef PG8_STAGE
#undef PG8_LDA
#undef PG8_LDB
#undef PG8_MMA
#undef PG8_WAIT_V
#undef PG8_WAIT_L
#undef PG8_BAR
#undef PG8_SCHED
}
}

constexpr int TOK = 16384, DM = 2048, FF = 5632, NIN = 11264, SEQ = 2048;
constexpr float EPS = 1e-6f, LOG2E = 1.4426950408889634f;
constexpr size_t MiB = (size_t)1 << 20;
constexpr size_t WS_CTL = 0;
constexpr size_t WS_WIN = 1 * MiB;
constexpr size_t WS_WA = 1 * MiB, WS_WB = 5 * MiB, WS_WO = 9 * MiB, WS_WPG = 17 * MiB, WS_WPP = 25 * MiB, WS_PB = 26 * MiB;
constexpr size_t WS_WGU = 45 * MiB;
constexpr size_t WS_WD = 89 * MiB;
constexpr size_t WS_XB = 111 * MiB;
constexpr size_t WS_BIG = 175 * MiB;
constexpr size_t WS_END = 527 * MiB;
constexpr size_t BIG_GA = 224 * MiB, BIG_PLE = 176 * MiB;
constexpr int C_SS1 = 0, C_SS2 = 16384, C_SS3 = 32768, C_SS4 = 49152, C_SSP = 65536, C_QUEUE = 81920, C_ZERO_END = 82048;

typedef unsigned short bf16;
#define LAS __attribute__((address_space(3)))
typedef LAS unsigned char* ldsp;
typedef float f32x4 __attribute__((ext_vector_type(4)));
typedef float f32x16 __attribute__((ext_vector_type(16)));
typedef unsigned u32x4 __attribute__((ext_vector_type(4)));
typedef unsigned u32x2 __attribute__((ext_vector_type(2)));
typedef short bf16x8 __attribute__((ext_vector_type(8)));
typedef short s16x4 __attribute__((ext_vector_type(4)));
typedef float f32x2_t __attribute__((ext_vector_type(2)));
typedef __bf16 bf16x2_t __attribute__((ext_vector_type(2)));

template <class T> __device__ __forceinline__ T lds_ld(ldsp p) { return *(const LAS T*)p; }
template <class T> __device__ __forceinline__ void lds_st(ldsp p, T v) { *(LAS T*)p = v; }
__device__ __forceinline__ unsigned cvtpk(float lo, float hi) { f32x2_t v = {lo, hi}; bf16x2_t b = __builtin_convertvector(v, bf16x2_t); return __builtin_bit_cast(unsigned, b); }
__device__ __forceinline__ float bflo(unsigned w) { return __uint_as_float(w << 16); }
__device__ __forceinline__ float bfhi(unsigned w) { return __uint_as_float(w & 0xffff0000u); }
__device__ __forceinline__ float sigm(float x) { return __builtin_amdgcn_rcpf(1.f + __builtin_amdgcn_exp2f(-x * LOG2E)); }
__device__ __forceinline__ int crow(int r, int hi) { return (r & 3) + 8 * (r >> 2) + 4 * hi; }
__device__ __forceinline__ s16x4 tr_ld(ldsp p) { typedef short v4i16_t __attribute__((ext_vector_type(4))); return __builtin_bit_cast(s16x4, __builtin_amdgcn_ds_read_tr16_b64_v4i16((LAS v4i16_t*)p)); }
__device__ __forceinline__ bf16x8 cat4(s16x4 a, s16x4 b) { return (bf16x8){a[0], a[1], a[2], a[3], b[0], b[1], b[2], b[3]}; }
__device__ __forceinline__ bf16x8 pack8(const f32x16& x, int s) { u32x4 p; p[0] = cvtpk(x[8 * s], x[8 * s + 1]); p[1] = cvtpk(x[8 * s + 2], x[8 * s + 3]); p[2] = cvtpk(x[8 * s + 4], x[8 * s + 5]); p[3] = cvtpk(x[8 * s + 6], x[8 * s + 7]); return __builtin_bit_cast(bf16x8, p); }
#define DPP_F(v, ctrl) __builtin_bit_cast(float, __builtin_amdgcn_update_dpp(0, __builtin_bit_cast(int, (v)), (ctrl), 0xf, 0xf, true))
#define MFMA32(a, b, c) __builtin_amdgcn_mfma_f32_32x32x16_bf16((a), (b), (c), 0, 0, 0)

struct EpiSwiglu {
    static constexpr bool PERM = true, AFTER_DRAIN = false;
    bf16* O; const float* ss;
    __device__ __forceinline__ void operator()(const pg8::f32x4 (&acc)[2][2][4][2], const pg8::Unit& u, int wr, int wc, int fr, int fq) const {
        const int col0 = u.pn * 128 + wc * 32 + 8 * fq, row0 = u.pm * 256 + wr * 64 + fr;
        float rsv[2][4];
#pragma unroll
        for (int ai = 0; ai < 2; ++ai)
#pragma unroll
            for (int m = 0; m < 4; ++m) rsv[ai][m] = ss[row0 + ai * 128 + m * 16];
#pragma unroll
        for (int ai = 0; ai < 2; ++ai)
#pragma unroll
            for (int m = 0; m < 4; ++m) {
                const int row = row0 + ai * 128 + m * 16;
                const float rs = rsqrtf(rsv[ai][m] * (1.f / DM) + EPS), c1 = -rs * LOG2E, rs2 = rs * rs;
                u32x4 w;
#pragma unroll
                for (int n = 0; n < 2; ++n) {
                    const pg8::f32x4 g = acc[ai][0][m][n], up = acc[ai][1][m][n];
                    float o4[4];
#pragma unroll
                    for (int k = 0; k < 4; ++k) o4[k] = (g[k] * up[k]) * (rs2 * __builtin_amdgcn_rcpf(1.f + __builtin_amdgcn_exp2f(g[k] * c1)));
                    w[2 * n] = cvtpk(o4[0], o4[1]); w[2 * n + 1] = cvtpk(o4[2], o4[3]);
                }
                *(u32x4*)(O + (size_t)row * FF + col0) = w;
            }
    }
};
struct EpiResid {
    static constexpr bool PERM = true, AFTER_DRAIN = false;
    const float* R; float* X; bf16* XB; float* ssout; float alpha;
    __device__ __forceinline__ void operator()(const pg8::f32x4 (&acc)[2][2][4][2], const pg8::Unit& u, int wr, int wc, int fr, int fq) const {
        const int row0 = u.pm * 256 + wr * 64 + fr, colb = u.pn * 256 + wc * 32 + 8 * fq;
#pragma unroll
        for (int ai = 0; ai < 2; ++ai) {
            pg8::f32x4 rv[4][2][2];
#pragma unroll
            for (int m = 0; m < 4; ++m)
#pragma unroll
                for (int bj = 0; bj < 2; ++bj) { const size_t off = (size_t)(row0 + ai * 128 + m * 16) * DM + colb + bj * 128;
                    rv[m][bj][0] = *(const pg8::f32x4*)(R + off); rv[m][bj][1] = *(const pg8::f32x4*)(R + off + 4); }
#pragma unroll
            for (int m = 0; m < 4; ++m) {
                const int row = row0 + ai * 128 + m * 16;
                float sq = 0.f;
#pragma unroll
                for (int bj = 0; bj < 2; ++bj) {
                    const size_t off = (size_t)row * DM + colb + bj * 128;
                    const pg8::f32x4 v0 = rv[m][bj][0] + acc[ai][bj][m][0] * alpha, v1 = rv[m][bj][1] + acc[ai][bj][m][1] * alpha;
                    *(pg8::f32x4*)(X + off) = v0; *(pg8::f32x4*)(X + off + 4) = v1;
                    u32x4 w; w[0] = cvtpk(v0[0], v0[1]); w[1] = cvtpk(v0[2], v0[3]); w[2] = cvtpk(v1[0], v1[1]); w[3] = cvtpk(v1[2], v1[3]);
                    *(u32x4*)(XB + off) = w;
                    sq += (v0[0] * v0[0] + v0[1] * v0[1]) + (v0[2] * v0[2] + v0[3] * v0[3]) + (v1[0] * v1[0] + v1[1] * v1[1]) + (v1[2] * v1[2] + v1[3] * v1[3]);
                }
                sq += __shfl_xor(sq, 16); sq += __shfl_xor(sq, 32);
                if (fq == 0) atomicAdd(ssout + row, sq);
            }
        }
    }
};
struct EpiProj {
    static constexpr bool PERM = true, AFTER_DRAIN = false;
    bf16* P; bf16* GA; const float* ss;
    __device__ __forceinline__ void operator()(const pg8::f32x4 (&acc)[2][2][4][2], const pg8::Unit& u, int wr, int wc, int fr, int fq) const {
        if (u.pn < 8) {
            bf16* qb_ = P + (size_t)(u.pn >> 2) * TOK * 1024 + (u.pn & 3) * 256 + 64 * wc + 8 * fq;
            const int rowq = u.pm * 256 + wr * 64 + fr;
            float rsq_[2][4];
#pragma unroll
            for (int ai = 0; ai < 2; ++ai)
#pragma unroll
                for (int m = 0; m < 4; ++m) rsq_[ai][m] = ss[rowq + ai * 128 + m * 16];
#pragma unroll
            for (int ai = 0; ai < 2; ++ai)
#pragma unroll
                for (int m = 0; m < 4; ++m) {
                    const int row = rowq + ai * 128 + m * 16;
                    const float rs = rsqrtf(rsq_[ai][m] * (1.f / DM) + EPS);
                    const pg8::f32x4 a0 = acc[ai][0][m][0] * rs, a1 = acc[ai][0][m][1] * rs, b0 = acc[ai][1][m][0] * rs, b1 = acc[ai][1][m][1] * rs;
                    float sq = (a0[0] * a0[0] + a0[1] * a0[1]) + (a0[2] * a0[2] + a0[3] * a0[3]) + (a1[0] * a1[0] + a1[1] * a1[1]) + (a1[2] * a1[2] + a1[3] * a1[3])
                             + (b0[0] * b0[0] + b0[1] * b0[1]) + (b0[2] * b0[2] + b0[3] * b0[3]) + (b1[0] * b1[0] + b1[1] * b1[1]) + (b1[2] * b1[2] + b1[3] * b1[3]);
                    sq += __shfl_xor(sq, 16); sq += __shfl_xor(sq, 32);
                    const float rn = rsqrtf(sq * (1.f / 64.f) + EPS);
                    u32x4 w0, w1;
                    w0[0] = cvtpk(a0[0] * rn, a0[1] * rn); w0[1] = cvtpk(a0[2] * rn, a0[3] * rn); w0[2] = cvtpk(a1[0] * rn, a1[1] * rn); w0[3] = cvtpk(a1[2] * rn, a1[3] * rn);
                    w1[0] = cvtpk(b0[0] * rn, b0[1] * rn); w1[1] = cvtpk(b0[2] * rn, b0[3] * rn); w1[2] = cvtpk(b1[0] * rn, b1[1] * rn); w1[3] = cvtpk(b1[2] * rn, b1[3] * rn);
                    *(u32x4*)(qb_ + (size_t)row * 1024) = w0; *(u32x4*)(qb_ + (size_t)row * 1024 + 32) = w1;
                }
            return;
        }
        const bool gate = u.pn >= 28;
        bf16* base; int ld, colt;
        if (!gate) { base = P + (size_t)(u.pn >> 2) * TOK * 1024; ld = 1024; colt = (u.pn & 3) * 256; }
        else { const int g = u.pn - 28; base = GA + (size_t)(g >> 3) * TOK * 2048; ld = 2048; colt = (g & 7) * 256; }
        colt += wc * 32 + 8 * fq;
        const int grp = u.pn >> 2;
        const int actm = (gate || grp == 4) ? 1 : ((grp == 3 || grp == 6) ? 2 : 0);
        const int row0 = u.pm * 256 + wr * 64 + fr;
        float rsv[2][4];
#pragma unroll
        for (int ai = 0; ai < 2; ++ai)
#pragma unroll
            for (int m = 0; m < 4; ++m) rsv[ai][m] = ss[row0 + ai * 128 + m * 16];
#pragma unroll
        for (int ai = 0; ai < 2; ++ai)
#pragma unroll
            for (int m = 0; m < 4; ++m) {
                const int row = row0 + ai * 128 + m * 16;
                const float rs = rsqrtf(rsv[ai][m] * (1.f / DM) + EPS);
#pragma unroll
                for (int bj = 0; bj < 2; ++bj) {
                    pg8::f32x4 v0 = acc[ai][bj][m][0], v1 = acc[ai][bj][m][1];
                    if (actm == 0) { v0 = v0 * rs; v1 = v1 * rs; }
                    else {
                        const float c1 = -rs * LOG2E, sc = (actm == 2) ? rs : 0.f;
#pragma unroll
                        for (int i = 0; i < 4; ++i) {
                            const float s0 = __builtin_amdgcn_rcpf(1.f + __builtin_amdgcn_exp2f(v0[i] * c1)), s1 = __builtin_amdgcn_rcpf(1.f + __builtin_amdgcn_exp2f(v1[i] * c1));
                            v0[i] = (actm == 2) ? v0[i] * sc * s0 : s0; v1[i] = (actm == 2) ? v1[i] * sc * s1 : s1; }
                    }
                    u32x4 w; w[0] = cvtpk(v0[0], v0[1]); w[1] = cvtpk(v0[2], v0[3]); w[2] = cvtpk(v1[0], v1[1]); w[3] = cvtpk(v1[2], v1[3]);
                    *(u32x4*)(base + (size_t)row * ld + colt + bj * 128) = w;
                }
            }
    }
};
template <bool FIRST> struct EpiMerge {
    static constexpr bool PERM = true, AFTER_DRAIN = false;
    const bf16* G; bf16* Mg;
    __device__ __forceinline__ void operator()(const pg8::f32x4 (&acc)[2][2][4][2], const pg8::Unit& u, int wr, int wc, int fr, int fq) const {
        const int row0 = u.pm * 256 + wr * 64 + fr, colb = u.pn * 256 + wc * 32 + 8 * fq;
#pragma unroll
        for (int ai = 0; ai < 2; ++ai) {
            u32x4 gv[4][2], pv[4][2];
#pragma unroll
            for (int m = 0; m < 4; ++m)
#pragma unroll
                for (int bj = 0; bj < 2; ++bj) { const size_t off = (size_t)(row0 + ai * 128 + m * 16) * DM + colb + bj * 128;
                    gv[m][bj] = *(const u32x4*)(G + off); if (!FIRST) pv[m][bj] = *(const u32x4*)(Mg + off); else pv[m][bj] = (u32x4){0u, 0u, 0u, 0u}; }
#pragma unroll
            for (int m = 0; m < 4; ++m)
#pragma unroll
                for (int bj = 0; bj < 2; ++bj) {
                    const size_t off = (size_t)(row0 + ai * 128 + m * 16) * DM + colb + bj * 128;
                    const u32x4 gw = gv[m][bj];
                    pg8::f32x4 v0 = acc[ai][bj][m][0], v1 = acc[ai][bj][m][1];
                    v0[0] *= bflo(gw[0]); v0[1] *= bfhi(gw[0]); v0[2] *= bflo(gw[1]); v0[3] *= bfhi(gw[1]);
                    v1[0] *= bflo(gw[2]); v1[1] *= bfhi(gw[2]); v1[2] *= bflo(gw[3]); v1[3] *= bfhi(gw[3]);
                    if (!FIRST) { const u32x4 pw = pv[m][bj];
                        v0[0] += bflo(pw[0]); v0[1] += bfhi(pw[0]); v0[2] += bflo(pw[1]); v0[3] += bfhi(pw[1]);
                        v1[0] += bflo(pw[2]); v1[1] += bfhi(pw[2]); v1[2] += bflo(pw[3]); v1[3] += bfhi(pw[3]); }
                    u32x4 w; w[0] = cvtpk(v0[0], v0[1]); w[1] = cvtpk(v0[2], v0[3]); w[2] = cvtpk(v1[0], v1[1]); w[3] = cvtpk(v1[2], v1[3]);
                    *(u32x4*)(Mg + off) = w;
                }
        }
    }
};
struct MergeOrder {
    pg8::StaticOrder so; int nt;
    __device__ __forceinline__ void init(int G_, int c_) { so.init(TOK, DM, G_, c_); nt = (so.nwg > c_) ? (so.nwg - c_ + G_ - 1) / G_ : 0; }
    __device__ __forceinline__ bool next(int i, pg8::Unit& u) const {
        if (i >= 2 * nt) return false;
        const bool second = i >= nt;
        if (!so.next(second ? i - nt : i, u)) return false;
        if (second) { u.pm += TOK / 256; u.pn += DM / 256; }
        return true;
    }
    __device__ __forceinline__ void a_ready(const pg8::Unit&) const {}
    __device__ __forceinline__ void done(const pg8::Unit&) const {}
};
struct EpiMerge2 {
    static constexpr bool PERM = true, AFTER_DRAIN = false;
    const bf16* GA_; const bf16* GB_; bf16* Mg;
    __device__ __forceinline__ void operator()(const pg8::f32x4 (&acc)[2][2][4][2], const pg8::Unit& u, int wr, int wc, int fr, int fq) const {
        const bool second = u.pm >= TOK / 256;
        const int pm = second ? u.pm - TOK / 256 : u.pm, pn = second ? u.pn - DM / 256 : u.pn;
        const bf16* G = second ? GB_ : GA_;
        const int row0 = pm * 256 + wr * 64 + fr, colb = pn * 256 + wc * 32 + 8 * fq;
#pragma unroll
        for (int ai = 0; ai < 2; ++ai) {
            u32x4 gv[4][2], pv[4][2];
#pragma unroll
            for (int m = 0; m < 4; ++m)
#pragma unroll
                for (int bj = 0; bj < 2; ++bj) { const size_t off = (size_t)(row0 + ai * 128 + m * 16) * DM + colb + bj * 128;
                    gv[m][bj] = *(const u32x4*)(G + off); pv[m][bj] = (u32x4){0u, 0u, 0u, 0u}; if (second) pv[m][bj] = *(const u32x4*)(Mg + off); }
#pragma unroll
            for (int m = 0; m < 4; ++m)
#pragma unroll
                for (int bj = 0; bj < 2; ++bj) {
                    const size_t off = (size_t)(row0 + ai * 128 + m * 16) * DM + colb + bj * 128;
                    const u32x4 gw = gv[m][bj], pw = pv[m][bj];
                    pg8::f32x4 v0 = acc[ai][bj][m][0], v1 = acc[ai][bj][m][1];
                    v0[0] = v0[0] * bflo(gw[0]) + bflo(pw[0]); v0[1] = v0[1] * bfhi(gw[0]) + bfhi(pw[0]); v0[2] = v0[2] * bflo(gw[1]) + bflo(pw[1]); v0[3] = v0[3] * bfhi(gw[1]) + bfhi(pw[1]);
                    v1[0] = v1[0] * bflo(gw[2]) + bflo(pw[2]); v1[1] = v1[1] * bfhi(gw[2]) + bfhi(pw[2]); v1[2] = v1[2] * bflo(gw[3]) + bflo(pw[3]); v1[3] = v1[3] * bfhi(gw[3]) + bfhi(pw[3]);
                    u32x4 w; w[0] = cvtpk(v0[0], v0[1]); w[1] = cvtpk(v0[2], v0[3]); w[2] = cvtpk(v1[0], v1[1]); w[3] = cvtpk(v1[2], v1[3]);
                    *(u32x4*)(Mg + off) = w;
                }
        }
    }
};
struct EpiPle {
    static constexpr bool PERM = true, AFTER_DRAIN = false;
    bf16* O; float* ssout;
    __device__ __forceinline__ void operator()(const pg8::f32x4 (&acc)[2][2][4][2], const pg8::Unit& u, int wr, int wc, int fr, int fq) const {
#pragma unroll
        for (int ai = 0; ai < 2; ++ai)
#pragma unroll
            for (int m = 0; m < 4; ++m) {
                const int row = u.pm * 256 + ai * 128 + wr * 64 + m * 16 + fr;
                float sq = 0.f;
#pragma unroll
                for (int bj = 0; bj < 2; ++bj) {
                    const size_t off = (size_t)row * DM + u.pn * 256 + bj * 128 + wc * 32 + 8 * fq;
                    const pg8::f32x4 v0 = acc[ai][bj][m][0], v1 = acc[ai][bj][m][1];
                    u32x4 w; w[0] = cvtpk(v0[0], v0[1]); w[1] = cvtpk(v0[2], v0[3]); w[2] = cvtpk(v1[0], v1[1]); w[3] = cvtpk(v1[2], v1[3]);
                    *(u32x4*)(O + off) = w;
                    sq += (v0[0] * v0[0] + v0[1] * v0[1]) + (v0[2] * v0[2] + v0[3] * v0[3]) + (v1[0] * v1[0] + v1[1] * v1[1]) + (v1[2] * v1[2] + v1[3] * v1[3]);
                }
                sq += __shfl_xor(sq, 16); sq += __shfl_xor(sq, 32);
                if (fq == 0) atomicAdd(ssout + row, sq);
            }
    }
};
struct EpiFinal {
    static constexpr bool PERM = true, AFTER_DRAIN = false;
    float* X; const bf16* PLE; const float* ss4; const float* ssp; const float* gpost;
    __device__ __forceinline__ void operator()(const pg8::f32x4 (&acc)[2][2][4][2], const pg8::Unit& u, int wr, int wc, int fr, int fq) const {
        const int row0 = u.pm * 256 + wr * 64 + fr, colb = u.pn * 256 + wc * 32 + 8 * fq;
        float s4[2][4], sp[2][4]; pg8::f32x4 gp[2][2];
#pragma unroll
        for (int ai = 0; ai < 2; ++ai)
#pragma unroll
            for (int m = 0; m < 4; ++m) { s4[ai][m] = ss4[row0 + ai * 128 + m * 16]; sp[ai][m] = ssp[row0 + ai * 128 + m * 16]; }
#pragma unroll
        for (int bj = 0; bj < 2; ++bj) { gp[bj][0] = *(const pg8::f32x4*)(gpost + colb + bj * 128); gp[bj][1] = *(const pg8::f32x4*)(gpost + colb + bj * 128 + 4); }
#pragma unroll
        for (int ai = 0; ai < 2; ++ai)
#pragma unroll
            for (int mp = 0; mp < 2; ++mp) {
                pg8::f32x4 xv[2][2][2]; u32x4 pl[2][2];
#pragma unroll
                for (int mm = 0; mm < 2; ++mm)
#pragma unroll
                    for (int bj = 0; bj < 2; ++bj) { const size_t off = (size_t)(row0 + ai * 128 + (2 * mp + mm) * 16) * DM + colb + bj * 128;
                        xv[mm][bj][0] = *(const pg8::f32x4*)(X + off); xv[mm][bj][1] = *(const pg8::f32x4*)(X + off + 4); pl[mm][bj] = *(const u32x4*)(PLE + off); }
#pragma unroll
                for (int mm = 0; mm < 2; ++mm) {
                    const int m = 2 * mp + mm;
                    const float rs = rsqrtf(s4[ai][m] * (1.f / DM) + EPS), rp = rsqrtf(sp[ai][m] * (1.f / DM) + EPS);
#pragma unroll
                    for (int bj = 0; bj < 2; ++bj) {
                        const size_t off = (size_t)(row0 + ai * 128 + m * 16) * DM + colb + bj * 128;
                        const u32x4 pw = pl[mm][bj];
                        const pg8::f32x4 g0 = gp[bj][0], g1 = gp[bj][1];
                        pg8::f32x4 x0 = xv[mm][bj][0], x1 = xv[mm][bj][1];
                        const pg8::f32x4 a0 = acc[ai][bj][m][0] * rs, a1 = acc[ai][bj][m][1] * rs;
                        x0[0] += sigm(a0[0]) * (bflo(pw[0]) * rp * g0[0]); x0[1] += sigm(a0[1]) * (bfhi(pw[0]) * rp * g0[1]);
                        x0[2] += sigm(a0[2]) * (bflo(pw[1]) * rp * g0[2]); x0[3] += sigm(a0[3]) * (bfhi(pw[1]) * rp * g0[3]);
                        x1[0] += sigm(a1[0]) * (bflo(pw[2]) * rp * g1[0]); x1[1] += sigm(a1[1]) * (bfhi(pw[2]) * rp * g1[1]);
                        x1[2] += sigm(a1[2]) * (bflo(pw[3]) * rp * g1[2]); x1[3] += sigm(a1[3]) * (bfhi(pw[3]) * rp * g1[3]);
                        *(pg8::f32x4*)(X + off) = x0; *(pg8::f32x4*)(X + off + 4) = x1;
                    }
                }
            }
    }
};

__device__ __forceinline__ float wave_sum(float v) {
#pragma unroll
    for (int o = 1; o < 64; o <<= 1) v += __shfl_xor(v, o);
    return v;
}
__device__ __forceinline__ void transpose_item(const float* __restrict__ W, int K, int N, const float* __restrict__ gain, bf16* WT, int mode, ldsp scr, int item, int lane) {
    const int nblk = N / 32, kb = item / nblk, nb = item % nblk, k0 = 64 * kb, n0 = 32 * nb;
    int r0;
    if (mode == 0) r0 = n0;
    else if (mode == 3) r0 = (n0 < 2048) ? ((n0 & ~255) + ((n0 >> 5) & 1) * 128 + ((n0 >> 6) & 3) * 32) : n0;
    else r0 = (n0 >> 7) * 256 + (mode == 2 ? 128 : 0) + (n0 & 127);
    float tv[32];
#pragma unroll
    for (int i = 0; i < 32; ++i) tv[i] = __builtin_nontemporal_load(&W[(size_t)(k0 + 2 * i + (lane >> 5)) * N + n0 + (lane & 31)]);
#pragma unroll
    for (int i = 0; i < 32; ++i) { const int kk = 2 * i + (lane >> 5); float v = tv[i]; if (gain) v *= gain[k0 + kk]; lds_st<float>(scr + 4 * (kk * 33 + (lane & 31)), v); }
    asm volatile("s_waitcnt lgkmcnt(0)" ::: "memory");
    const int c = lane & 7;
#pragma unroll
    for (int j = 0; j < 4; ++j) { const int n = (lane >> 3) + 8 * j; ldsp s = scr + 4 * ((8 * c) * 33 + n);
        u32x4 o; o[0] = cvtpk(lds_ld<float>(s), lds_ld<float>(s + 132)); o[1] = cvtpk(lds_ld<float>(s + 264), lds_ld<float>(s + 396));
        o[2] = cvtpk(lds_ld<float>(s + 528), lds_ld<float>(s + 660)); o[3] = cvtpk(lds_ld<float>(s + 792), lds_ld<float>(s + 924));
        *(u32x4*)(WT + (size_t)(r0 + n) * K + k0 + 8 * c) = o; }
    asm volatile("s_waitcnt lgkmcnt(0)" ::: "memory");
}
#define RLX_AGENT __ATOMIC_RELAXED, __HIP_MEMORY_SCOPE_AGENT
#define XB_TMO      128
#define XB_XCNT(j)  (256  + 64 * (j))
#define XB_XSUB(j)  (1280 + 64 * (j))
#define XB_XGEN(j)  (2304 + 64 * (j))
#define XB_TOP      3328
#define XB_TOPGEN   3392
#define XCD_BAR_WORDS 3456
#define XB_SPIN_CAP (1u << 18)

__device__ __forceinline__ unsigned xb_ld(unsigned* p)              { return __hip_atomic_load(p, __ATOMIC_RELAXED, __HIP_MEMORY_SCOPE_AGENT); }
__device__ __forceinline__ unsigned xb_add(unsigned* p, unsigned v) { return __hip_atomic_fetch_add(p, v, __ATOMIC_RELAXED, __HIP_MEMORY_SCOPE_AGENT); }
__device__ __forceinline__ unsigned xb_xcc_id() { return (unsigned)__builtin_amdgcn_s_getreg((3 << 11) | 20) & 0xFu; }
#define XB_SPIN(cond, bar) do { unsigned _sp = 0; while (cond) { __builtin_amdgcn_s_sleep(1); \
    if ((++_sp & 255u) == 0u) { if (xb_ld(&(bar)[XB_TMO])) break; if (_sp > XB_SPIN_CAP) { atomicAdd(&(bar)[XB_TMO], 1u); break; } } } } while (0)

struct XcdBarrier {
    unsigned* bar; unsigned x;
    volatile LAS unsigned* st;
};

__device__ __forceinline__ XcdBarrier xcd_barrier_post(unsigned* bar, volatile LAS unsigned* st) {
    XcdBarrier b; b.bar = bar; b.x = xb_xcc_id(); b.st = st;
    if (threadIdx.x == 0) (void)xb_add(&bar[XB_XCNT(b.x)], 1u);
    return b;
}
__device__ __forceinline__ void xcd_barrier_complete(unsigned* bar, unsigned x, unsigned& nloc, unsigned& nx) {
    const unsigned G = gridDim.x * gridDim.y * gridDim.z;
    unsigned sum, cnt, mine, sp = 0u;
    for (;;) {
        sum = 0u; cnt = 0u; mine = 0u;
#pragma unroll
        for (unsigned j = 0; j < 16; ++j) { const unsigned c = xb_ld(&bar[XB_XCNT(j)]); sum += c; cnt += (c > 0u) ? 1u : 0u; mine = (j == x) ? c : mine; }
        if (sum == G) break;
        __builtin_amdgcn_s_sleep(1);
        if ((++sp & 255u) == 0u) { if (xb_ld(&bar[XB_TMO])) break; if (sp > XB_SPIN_CAP) { atomicAdd(&bar[XB_TMO], 1u); break; } }
    }
    nloc = mine > 0u ? mine : 1u; nx = cnt > 0u ? cnt : 1u;
}

__device__ __forceinline__ void xcd_barrier(const XcdBarrier& b) {
    asm volatile("s_waitcnt vmcnt(0)" ::: "memory");
    __syncthreads();
    if (threadIdx.x == 0) {
        unsigned* bar = b.bar;
        __builtin_amdgcn_s_waitcnt(0);
        unsigned nloc = b.st[0], nx = b.st[1];
        if (nloc == 0u) { xcd_barrier_complete(bar, b.x, nloc, nx); b.st[0] = nloc; b.st[1] = nx; }
        const unsigned old = xb_add(&bar[XB_XSUB(b.x)], 1u);
        const unsigned gen = old / nloc;
        if (old + 1u == (gen + 1u) * nloc) {
            __builtin_amdgcn_fence(__ATOMIC_RELEASE, "agent");
            asm volatile("s_waitcnt vmcnt(0)" ::: "memory");
            const unsigned og = xb_add(&bar[XB_TOP], 1u);
            const unsigned tg = og / nx;
            if (og + 1u == (tg + 1u) * nx) xb_add(&bar[XB_TOPGEN], 1u);
            else XB_SPIN(xb_ld(&bar[XB_TOPGEN]) == tg, bar);
            __builtin_amdgcn_fence(__ATOMIC_ACQUIRE, "agent");
            xb_add(&bar[XB_XGEN(b.x)], 1u);
            asm volatile("s_waitcnt vmcnt(0)" ::: "memory");
        } else {
            XB_SPIN(xb_ld(&bar[XB_XGEN(b.x)]) == gen, bar);
            __builtin_amdgcn_fence(__ATOMIC_ACQUIRE, "agent");
            asm volatile("s_waitcnt vmcnt(0)" ::: "memory");
        }
    }
    __syncthreads();
}

constexpr int A_KP = 144, A_KT = 64 * A_KP, A_VP = 320, A_VT = 64 * A_VP, A_STAGE = 2 * A_KT + A_VT;
constexpr int A_TAB = 131072, A_WSF = A_TAB + 512, A_QSLOT = A_WSF + 1024;
constexpr int LDS_BYTES = 147456;
static_assert(2 * A_STAGE <= 131072 && A_QSLOT + 64 <= LDS_BYTES, "attention LDS map");

__device__ __forceinline__ void attn_unit(ldsp L, int bh, int qb, const bf16* __restrict__ dq, const bf16* __restrict__ dk, const bf16* __restrict__ dv, bf16* __restrict__ ya,
                                          const float* __restrict__ qn, const float* __restrict__ kn, const float* __restrict__ relb, const float* __restrict__ subln, float lam) {
    const int tid = threadIdx.x, lane = tid & 63, r32 = lane & 31, hi = lane >> 5, w = __builtin_amdgcn_readfirstlane(tid >> 6), j = w >> 2, qs = w & 3;
    const int b = bh >> 3, h = bh & 7, q0 = qb * 128, qrow0 = q0 + 32 * qs;
    const size_t tok0 = (size_t)b * SEQ;
    if (tid < 128) { const int d = tid; int bk = d;
        if (d >= 16) { bk = 16 + (int)(logf((float)d / 16.f) / 2.0794415416798357f * 16.f); bk = bk > 31 ? 31 : bk; }
        lds_st<float>(L + A_TAB + 4 * d, (relb[bk * 8 + h] - relb[31 * 8 + h]) * LOG2E); }
    const int kr = tid >> 3, c8 = tid & 7;
    const bf16* gk = dk + (tok0 + kr) * 1024 + h * 128 + 8 * c8;
    const bf16* gv = dv + (tok0 + kr) * 1024 + h * 128 + 8 * c8;
    u32x4 k0r = *(const u32x4*)gk, k1r = *(const u32x4*)(gk + 64), v0r = *(const u32x4*)gv, v1r = *(const u32x4*)(gv + 64);
    bf16x8 qr[4];
    { const bf16* qp = dq + (tok0 + qrow0 + r32) * 1024 + h * 128 + j * 64 + hi * 8;
      u32x4 raw[4];
#pragma unroll
      for (int d0 = 0; d0 < 4; ++d0) raw[d0] = *(const u32x4*)(qp + 16 * d0);
      const float rs = 0.125f * LOG2E;
#pragma unroll
      for (int d0 = 0; d0 < 4; ++d0) { u32x4 p;
#pragma unroll
          for (int i = 0; i < 4; ++i) { const int d = 16 * d0 + 8 * hi + 2 * i;
              p[i] = cvtpk(bflo(raw[d0][i]) * rs * qn[d] * kn[d], bfhi(raw[d0][i]) * rs * qn[d + 1] * kn[d + 1]); }
          qr[d0] = __builtin_bit_cast(bf16x8, p); } }
#define A_LOAD(t) do { const size_t o_ = (size_t)(t) * 64 * 1024; k0r = *(const u32x4*)(gk + o_); k1r = *(const u32x4*)(gk + o_ + 64); v0r = *(const u32x4*)(gv + o_); v1r = *(const u32x4*)(gv + o_ + 64); } while (0)
#define A_STORE(buf) do { ldsp s_ = L + (buf) * A_STAGE; lds_st<u32x4>(s_ + kr * A_KP + c8 * 16, k0r); lds_st<u32x4>(s_ + A_KT + kr * A_KP + c8 * 16, k1r); \
        lds_st<u32x4>(s_ + 2 * A_KT + kr * A_VP + c8 * 16, v0r); lds_st<u32x4>(s_ + 2 * A_KT + kr * A_VP + 128 + c8 * 16, v1r); } while (0)
    const int NT = 2 * qb + 2;
    A_STORE(0);
    A_LOAD(1);
    __syncthreads();
    f32x16 o[4]; o[0] = f32x16{}; o[1] = f32x16{}; o[2] = f32x16{}; o[3] = f32x16{};
    f32x16 lacc = f32x16{};
    const bf16x8 ones = (bf16x8){0x3F80, 0x3F80, 0x3F80, 0x3F80, 0x3F80, 0x3F80, 0x3F80, 0x3F80};
    const ldsp wsf = L + A_WSF + w * 128;
    const int qpos = qrow0 + r32;
    for (int t = 0; t < NT; ++t) {
        if (t + 1 < NT) A_STORE((t + 1) & 1);
        if (t + 2 < NT) A_LOAD(t + 2);
        const int kb = 64 * t;
        if (kb <= qrow0 + 31) {
            const ldsp Kj = L + (t & 1) * A_STAGE + j * A_KT + r32 * A_KP + hi * 16;
            f32x16 p0 = f32x16{}, p1 = f32x16{};
#pragma unroll
            for (int d0 = 0; d0 < 4; ++d0) { const bf16x8 a0 = lds_ld<bf16x8>(Kj + d0 * 32), a1 = lds_ld<bf16x8>(Kj + 32 * A_KP + d0 * 32);
                p0 = MFMA32(a0, qr[d0], p0); p1 = MFMA32(a1, qr[d0], p1); }
            if (kb + 63 + 128 > qrow0) {
#pragma unroll
                for (int r = 0; r < 16; ++r) { const int d = qpos - (kb + crow(r, hi)), d2 = d - 32;
                    const float b0 = lds_ld<float>(L + A_TAB + 4 * (d < 0 ? 0 : (d > 127 ? 127 : d))), b1 = lds_ld<float>(L + A_TAB + 4 * (d2 < 0 ? 0 : (d2 > 127 ? 127 : d2)));
                    p0[r] = d < 0 ? -1e30f : p0[r] + b0; p1[r] = d2 < 0 ? -1e30f : p1[r] + b1; }
            }
#pragma unroll
            for (int r = 0; r < 16; ++r) { p0[r] = __builtin_amdgcn_exp2f(p0[r]); p1[r] = __builtin_amdgcn_exp2f(p1[r]); }
            bf16x8 pa[4]; pa[0] = pack8(p0, 0); pa[1] = pack8(p0, 1); pa[2] = pack8(p1, 0); pa[3] = pack8(p1, 1);
            lacc = MFMA32(pa[0], ones, lacc); lacc = MFMA32(pa[1], ones, lacc); lacc = MFMA32(pa[2], ones, lacc); lacc = MFMA32(pa[3], ones, lacc);
            const ldsp vbase = L + (t & 1) * A_STAGE + 2 * A_KT + (4 * hi + ((lane & 15) >> 2)) * A_VP + (16 * ((lane >> 4) & 1) + 4 * (lane & 3)) * 2;
#pragma unroll
            for (int s = 0; s < 4; ++s)
#pragma unroll
                for (int vb = 0; vb < 4; ++vb) { const s16x4 lo = tr_ld(vbase + s * 16 * A_VP + vb * 64), hh = tr_ld(vbase + s * 16 * A_VP + 8 * A_VP + vb * 64);
                    o[vb] = MFMA32(pa[s], cat4(lo, hh), o[vb]); }
        }
        __syncthreads();
    }
#undef A_LOAD
#undef A_STORE
#pragma unroll
    for (int g = 0; g < 4; ++g) {
#pragma unroll
        for (int i = 0; i < 4; ++i) { const float inv = __builtin_amdgcn_rcpf(lacc[4 * g + i]);
#pragma unroll
            for (int vb = 0; vb < 4; ++vb) lds_st<float>(L + j * 65536 + ((qs * 32 + 8 * g + 4 * hi + i) * 128 + 32 * vb + r32) * 4, o[vb][4 * g + i] * inv); } }
    __syncthreads();
    { const int row = tid >> 2, qd = tid & 3; const ldsp e0 = L + (row * 128 + 32 * qd) * 4;
      float d[32]; float ssq = 0.f;
#pragma unroll
      for (int i = 0; i < 8; ++i) { const f32x4 a = lds_ld<f32x4>(e0 + 16 * i), c = lds_ld<f32x4>(e0 + 65536 + 16 * i);
#pragma unroll
          for (int k = 0; k < 4; ++k) { const float x = a[k] - lam * c[k]; d[4 * i + k] = x; ssq += x * x; } }
      ssq += DPP_F(ssq, 0xB1); ssq += DPP_F(ssq, 0x4E);
      const float rs = rsqrtf(ssq * (1.f / 128.f) + EPS) * 0.8f;
      bf16* yp = ya + (tok0 + q0 + row) * 1024 + h * 128 + 32 * qd;
#pragma unroll
      for (int i = 0; i < 4; ++i) { u32x4 wv;
#pragma unroll
          for (int k = 0; k < 4; ++k) { const int c = 8 * i + 2 * k; wv[k] = cvtpk(d[c] * rs * subln[32 * qd + c], d[c + 1] * rs * subln[32 * qd + c + 1]); }
          *(u32x4*)(yp + 8 * i) = wv; } }
    __syncthreads();
}

constexpr int H_QP = 272, H_TP = 80, H_VP = 320;
constexpr int H_QT = 0, H_KT = 32 * H_QP, H_KTT = 2 * 32 * H_QP, H_V = H_KTT + 128 * H_TP, H_DEC = H_V + 32 * H_VP, H_O = H_DEC + 512, H_BUF = H_O + 32 * 512;
static_assert(2 * H_BUF <= 131072, "hgrn LDS map");

__device__ __forceinline__ void hgrn_unit(ldsp L, int bh, const bf16* __restrict__ hq, const bf16* __restrict__ hf, const bf16* __restrict__ hv, const bf16* __restrict__ hg, bf16* __restrict__ yb,
                                          const float* __restrict__ lbl, const float* __restrict__ gnorm) {
    const int tid = threadIdx.x, lane = tid & 63, r32 = lane & 31, hi = lane >> 5, w = __builtin_amdgcn_readfirstlane(tid >> 6);
    const int b = bh >> 3, h = bh & 7;
    const size_t tok0 = (size_t)b * SEQ;
    const bool prep = w >= 4;
    const int pt = tid & 255, cpl = lane & 15, tq = lane >> 4, k0 = 2 * (16 * (w & 3) + cpl);
    const float lb0 = sigm(lbl[h * 128 + k0] - lbl[1024 + h * 128 + k0]), lb1 = sigm(lbl[h * 128 + k0 + 1] - lbl[1024 + h * 128 + k0 + 1]);
    const int vrow = pt >> 3, vc8 = pt & 7;
    f32x16 S[4]; S[0] = f32x16{}; S[1] = f32x16{}; S[2] = f32x16{}; S[3] = f32x16{};
    const int vb = w & 3;
    unsigned qw[8], fw[8]; u32x4 v0r = {0u, 0u, 0u, 0u}, v1r = {0u, 0u, 0u, 0u}, g0r = {0u, 0u, 0u, 0u}, g1r = {0u, 0u, 0u, 0u};
#pragma unroll
    for (int i = 0; i < 8; ++i) { qw[i] = 0u; fw[i] = 0u; }
    auto do_load = [&](int c) {
        const size_t base = (tok0 + 32 * c + 8 * tq) * 1024 + h * 128 + k0;
#pragma unroll
        for (int i = 0; i < 8; ++i) { qw[i] = *(const unsigned*)(hq + base + (size_t)i * 1024); fw[i] = *(const unsigned*)(hf + base + (size_t)i * 1024); }
        const bf16* vsrc = hv + (tok0 + 32 * c + vrow) * 1024 + h * 128 + 8 * vc8;
        v0r = *(const u32x4*)vsrc; v1r = *(const u32x4*)(vsrc + 64);
    };
    auto do_loadg = [&](int c) {
        const size_t off = (tok0 + 32 * c + (pt >> 3)) * 1024 + h * 128 + 16 * (pt & 7);
        g0r = *(const u32x4*)(hg + off); g1r = *(const u32x4*)(hg + off + 8);
    };
    auto do_prep = [&](int c) {
        const ldsp B = L + (c & 1) * H_BUF;
        const u32x4 v0 = v0r, v1 = v1r;
        float qt[2][8], kt[2][8];
#pragma unroll
        for (int ch = 0; ch < 2; ++ch) {
            const float lb = ch ? lb1 : lb0;
            float P = 1.f, Pl[8], kk[8];
#pragma unroll
            for (int i = 0; i < 8; ++i) { const float sg = ch ? bfhi(fw[i]) : bflo(fw[i]); const float f = lb + (1.f - lb) * sg; P *= f; Pl[i] = P; kk[i] = (1.f - lb) * (1.f - sg); }
            const float T0 = __shfl(P, cpl), T1 = __shfl(P, 16 + cpl), T2 = __shfl(P, 32 + cpl), T3 = __shfl(P, 48 + cpl);
            const float pre = tq == 0 ? 1.f : (tq == 1 ? T0 : (tq == 2 ? T0 * T1 : T0 * T1 * T2));
            if (tq == 0) lds_st<float>(B + H_DEC + 4 * (k0 + ch), (T0 * T1) * (T2 * T3));
#pragma unroll
            for (int i = 0; i < 8; ++i) { const float Pt = pre * Pl[i]; const float qv = ch ? bfhi(qw[i]) : bflo(qw[i]);
                qt[ch][i] = qv * Pt; kt[ch][i] = kk[i] * __builtin_amdgcn_rcpf(fmaxf(Pt, 1e-30f)); }
        }
#pragma unroll
        for (int i = 0; i < 8; ++i) { lds_st<unsigned>(B + H_QT + (8 * tq + i) * H_QP + k0 * 2, cvtpk(qt[0][i], qt[1][i])); lds_st<unsigned>(B + H_KT + (8 * tq + i) * H_QP + k0 * 2, cvtpk(kt[0][i], kt[1][i])); }
#pragma unroll
        for (int ch = 0; ch < 2; ++ch) { u32x4 t4; t4[0] = cvtpk(kt[ch][0], kt[ch][1]); t4[1] = cvtpk(kt[ch][2], kt[ch][3]); t4[2] = cvtpk(kt[ch][4], kt[ch][5]); t4[3] = cvtpk(kt[ch][6], kt[ch][7]);
            lds_st<u32x4>(B + H_KTT + (k0 + ch) * H_TP + 16 * tq, t4); }
        lds_st<u32x4>(B + H_V + vrow * H_VP + vc8 * 16, v0); lds_st<u32x4>(B + H_V + vrow * H_VP + 128 + vc8 * 16, v1);
    };
    auto do_final = [&](int c) {
        const ldsp Ob = L + (c & 1) * H_BUF + H_O;
        const int t = pt >> 3, v0 = 16 * (pt & 7);
        float ov[16]; float ssq = 0.f;
#pragma unroll
        for (int i = 0; i < 4; ++i) { const f32x4 a = lds_ld<f32x4>(Ob + (t * 128 + v0 + 4 * i) * 4);
#pragma unroll
            for (int k = 0; k < 4; ++k) { ov[4 * i + k] = a[k]; ssq += a[k] * a[k]; } }
        ssq += DPP_F(ssq, 0xB1); ssq += DPP_F(ssq, 0x4E); ssq += DPP_F(ssq, 0x141);
        const float rs = rsqrtf(ssq * (1.f / 128.f) + EPS);
        const size_t off = (tok0 + 32 * c + t) * 1024 + h * 128 + v0;
        const u32x4 g0 = g0r, g1 = g1r;
        u32x4 w0, w1;
#pragma unroll
        for (int k = 0; k < 4; ++k) { const float a = bflo(g0[k]), c2 = bfhi(g0[k]), a1 = bflo(g1[k]), c1 = bfhi(g1[k]);
            w0[k] = cvtpk(ov[2 * k] * rs * gnorm[v0 + 2 * k] * a, ov[2 * k + 1] * rs * gnorm[v0 + 2 * k + 1] * c2);
            w1[k] = cvtpk(ov[8 + 2 * k] * rs * gnorm[v0 + 8 + 2 * k] * a1, ov[8 + 2 * k + 1] * rs * gnorm[v0 + 8 + 2 * k + 1] * c1); }
        *(u32x4*)(yb + off) = w0; *(u32x4*)(yb + off + 8) = w1;
    };
    auto do_mfma = [&](int c) {
        const ldsp B = L + (c & 1) * H_BUF;
        const ldsp Qt = B + H_QT + r32 * H_QP, Kt = B + H_KT + r32 * H_QP;
        f32x16 D = f32x16{};
#pragma unroll
        for (int kk = 0; kk < 8; ++kk) { const bf16x8 a = lds_ld<bf16x8>(Kt + (16 * kk + 8 * hi) * 2), bq = lds_ld<bf16x8>(Qt + (16 * kk + 8 * hi) * 2); D = MFMA32(a, bq, D); }
#pragma unroll
        for (int r = 0; r < 16; ++r) if (crow(r, hi) > r32) D[r] = 0.f;
        const bf16x8 aD0 = pack8(D, 0), aD1 = pack8(D, 1);
        const ldsp vbase = B + H_V + ((lane & 15) >> 2) * H_VP + (32 * vb + 16 * ((lane >> 4) & 1) + 4 * (lane & 3)) * 2;
        f32x16 o = f32x16{};
        { const s16x4 lo = tr_ld(vbase + (4 * hi) * H_VP), hh = tr_ld(vbase + (8 + 4 * hi) * H_VP); o = MFMA32(aD0, cat4(lo, hh), o); }
        { const s16x4 lo = tr_ld(vbase + (16 + 4 * hi) * H_VP), hh = tr_ld(vbase + (24 + 4 * hi) * H_VP); o = MFMA32(aD1, cat4(lo, hh), o); }
#pragma unroll
        for (int kb = 0; kb < 4; ++kb)
#pragma unroll
            for (int s2 = 0; s2 < 2; ++s2) { const u32x2 q1 = lds_ld<u32x2>(Qt + (32 * kb + 16 * s2 + 4 * hi) * 2), q2 = lds_ld<u32x2>(Qt + (32 * kb + 16 * s2 + 8 + 4 * hi) * 2);
                const u32x4 qa = {q1[0], q1[1], q2[0], q2[1]};
                o = MFMA32(__builtin_bit_cast(bf16x8, qa), pack8(S[kb], s2), o); }
        const ldsp Ob = B + H_O;
#pragma unroll
        for (int r = 0; r < 16; ++r) lds_st<float>(Ob + (crow(r, hi) * 128 + 32 * vb + r32) * 4, o[r]);
#pragma unroll
        for (int kb = 0; kb < 4; ++kb) {
#pragma unroll
            for (int s2 = 0; s2 < 2; ++s2) { const bf16x8 ka = lds_ld<bf16x8>(B + H_KTT + (32 * kb + r32) * H_TP + (16 * s2 + 8 * hi) * 2);
                const s16x4 lo = tr_ld(vbase + (16 * s2 + 8 * hi) * H_VP), hh = tr_ld(vbase + (16 * s2 + 8 * hi + 4) * H_VP);
                S[kb] = MFMA32(ka, cat4(lo, hh), S[kb]); }
#pragma unroll
            for (int g = 0; g < 4; ++g) { const f32x4 d4 = lds_ld<f32x4>(B + H_DEC + (32 * kb + 8 * g + 4 * hi) * 4);
#pragma unroll
                for (int i = 0; i < 4; ++i) S[kb][4 * g + i] *= d4[i]; }
        }
    };
    if (prep) { do_load(0); do_prep(0); do_load(1); }
    __syncthreads();
    for (int c = 0; c < 64; ++c) {
        if (prep) {
            if (c + 1 < 64) do_prep(c + 1);
            if (c + 2 < 64) do_load(c + 2);
            if (c > 0) do_final(c - 1);
            do_loadg(c);
        }
        else do_mfma(c);
        __syncthreads();
    }
    if (prep) do_final(63);
    __syncthreads();
}

struct Args { const float* in[29]; float* out; unsigned char* ws; int ph_lo, ph_hi; };
constexpr int N_PHASES = 10;
constexpr size_t WS_BAR = 512 * 1024;
constexpr int LDS_BARST = 133120;

__global__ void __launch_bounds__(512, 2) fwd_megakernel(Args a) {
    extern __shared__ __attribute__((aligned(16))) unsigned char lds_raw[];
    const ldsp L = (ldsp)lds_raw;
    PG8_LAS unsigned char* const LG = (PG8_LAS unsigned char*)lds_raw;
    cg::grid_group grid = cg::this_grid();
    const int tid = threadIdx.x, lane = tid & 63, wave = __builtin_amdgcn_readfirstlane(tid >> 6);
    const int G = gridDim.x, bx = blockIdx.x;
    unsigned char* ws = a.ws;
    float* ctl = (float*)(ws + WS_CTL);
    bf16* Win_t = (bf16*)(ws + WS_WIN); bf16* Wgu_t = (bf16*)(ws + WS_WGU); bf16* Wd_t = (bf16*)(ws + WS_WD);
    bf16* Wa_t = (bf16*)(ws + WS_WA); bf16* Wb_t = (bf16*)(ws + WS_WB); bf16* Wo_t = (bf16*)(ws + WS_WO); bf16* Wpg_t = (bf16*)(ws + WS_WPG); bf16* Wpp_t = (bf16*)(ws + WS_WPP); bf16* PB = (bf16*)(ws + WS_PB);
    bf16* XB = (bf16*)(ws + WS_XB); bf16* YA = XB; bf16* YB = XB + (size_t)TOK * 1024;
    bf16* ACT = (bf16*)(ws + WS_BIG); bf16* PROJ = ACT; bf16* GAB = (bf16*)(ws + WS_BIG + BIG_GA); bf16* MERGED = ACT; bf16* PLE = (bf16*)(ws + WS_BIG + BIG_PLE);
    float* OUT = a.out;
    const int lo = a.ph_lo, hi_ = a.ph_hi;
    if (tid < 4) lds_st<unsigned>(L + LDS_BARST + 4 * tid, 0u);
    __syncthreads();
    XcdBarrier xbar; xbar.bar = (unsigned*)(ws + WS_BAR); xbar.x = 0; xbar.st = nullptr;
    if (hi_ - lo > 1) xbar = xcd_barrier_post((unsigned*)(ws + WS_BAR), (volatile LAS unsigned*)(L + LDS_BARST));
    if (lo < 0) grid.sync();
#define IN(k) (lo <= (k) && (k) < hi_)
#define SEAM(k) do { if (IN(k) && IN((k) + 1)) xcd_barrier(xbar); } while (0)
#define RUN_GEMM(EPI, Aptr, Bptr, N_, K_, Eobj) do { pg8::Gemm g_{(const pg8::bf16_t*)(Aptr), (const pg8::bf16_t*)(Bptr), TOK, (N_), (K_)}; pg8::StaticOrder S_; S_.init(TOK, (N_), G, bx); \
        pg8::gemm_phase<EPI, pg8::StaticOrder, true, true>(LG, g_, S_, Eobj); } while (0)

    if (IN(0)) {
        const int gw = bx * 8 + wave, NGW = G * 8;
        for (int i = bx * 512 + tid; i < C_ZERO_END - C_SS2; i += G * 512) ctl[C_SS2 + i] = 0.f;
        const ldsp scr = L + wave * 16384;
        constexpr int I_GU = (DM / 64) * (FF / 32), I_D = (FF / 64) * (DM / 32), I_IN = (DM / 64) * (NIN / 32);
        for (int it = gw; it < 2 * I_GU + I_D + I_IN; it += NGW) {
            int r = it;
            if (r < I_GU) { transpose_item(a.in[3], DM, FF, a.in[2], Wgu_t, 1, scr, r, lane); continue; } r -= I_GU;
            if (r < I_GU) { transpose_item(a.in[4], DM, FF, a.in[2], Wgu_t, 2, scr, r, lane); continue; } r -= I_GU;
            if (r < I_D) { transpose_item(a.in[5], FF, DM, nullptr, Wd_t, 0, scr, r, lane); continue; } r -= I_D;
            transpose_item(a.in[7], DM, NIN, a.in[6], Win_t, 3, scr, r, lane);
        }
        for (int m = gw; m < TOK; m += NGW) {
            const f32x4* xr = (const f32x4*)(a.in[0] + (size_t)m * DM) + lane;
            f32x4 v[8]; float s = 0.f;
#pragma unroll
            for (int j = 0; j < 8; ++j) { v[j] = __builtin_nontemporal_load(xr + 64 * j); s += (v[j][0] * v[j][0] + v[j][1] * v[j][1]) + (v[j][2] * v[j][2] + v[j][3] * v[j][3]); }
            s = wave_sum(s);
            if (lane == 0) ctl[C_SS1 + m] = s;
            u32x2* o8 = (u32x2*)(XB + (size_t)m * DM) + lane;
#pragma unroll
            for (int j = 0; j < 8; ++j) { u32x2 w2; w2[0] = cvtpk(v[j][0], v[j][1]); w2[1] = cvtpk(v[j][2], v[j][3]); o8[64 * j] = w2; }
        }
    }
    SEAM(0);
    if (IN(1)) { EpiSwiglu E{ACT, ctl + C_SS1}; RUN_GEMM(EpiSwiglu, XB, Wgu_t, 2 * FF, DM, E); }
    SEAM(1);
    if (IN(2)) { EpiResid E{a.in[0], OUT, XB, ctl + C_SS2, 0.5f}; RUN_GEMM(EpiResid, ACT, Wd_t, DM, FF, E); }
    SEAM(2);
    if (IN(3)) { EpiProj E{PROJ, GAB, ctl + C_SS2}; RUN_GEMM(EpiProj, XB, Win_t, NIN, DM, E); }
    SEAM(3);
    if (IN(4)) {
        const size_t PS = (size_t)TOK * 1024;
        if (bx < 64 && G > 64) {
            hgrn_unit(L, bx, PROJ + 3 * PS, PROJ + 4 * PS, PROJ + 5 * PS, PROJ + 6 * PS, YB, a.in[16], a.in[17]);
        } else {
            if (G <= 64) { for (int u = bx; u < 64; u += G) hgrn_unit(L, u, PROJ + 3 * PS, PROJ + 4 * PS, PROJ + 5 * PS, PROJ + 6 * PS, YB, a.in[16], a.in[17]); }
            const int nb0 = (G > 64) ? 64 : 0;
            const int gw = (bx - nb0) * 8 + wave, NGW = (G - nb0) * 8;
            const ldsp scr = L + wave * 16384;
            constexpr int I_A = (1024 / 64) * (DM / 32), I_O = (DM / 64) * (DM / 32), I_PP = (256 / 64) * (DM / 32), I_GU = (DM / 64) * (FF / 32), I_D = (FF / 64) * (DM / 32);
            for (int it = gw; it < 2 * I_A + 2 * I_O + I_PP + 2 * I_GU + I_D; it += NGW) {
                int r = it;
                if (r < I_A) { transpose_item(a.in[18], 1024, DM, nullptr, Wa_t, 0, scr, r, lane); continue; } r -= I_A;
                if (r < I_A) { transpose_item(a.in[19], 1024, DM, nullptr, Wb_t, 0, scr, r, lane); continue; } r -= I_A;
                if (r < I_O) { transpose_item(a.in[20], DM, DM, nullptr, Wo_t, 0, scr, r, lane); continue; } r -= I_O;
                if (r < I_O) { transpose_item(a.in[26], DM, DM, a.in[25], Wpg_t, 0, scr, r, lane); continue; } r -= I_O;
                if (r < I_PP) { transpose_item(a.in[27], 256, DM, nullptr, Wpp_t, 0, scr, r, lane); continue; } r -= I_PP;
                if (r < I_GU) { transpose_item(a.in[22], DM, FF, a.in[21], Wgu_t, 1, scr, r, lane); continue; } r -= I_GU;
                if (r < I_GU) { transpose_item(a.in[23], DM, FF, a.in[21], Wgu_t, 2, scr, r, lane); continue; } r -= I_GU;
                transpose_item(a.in[24], FF, DM, nullptr, Wd_t, 0, scr, r, lane);
            }
            for (int i = (bx - nb0) * 512 + tid; i < TOK * 256 / 8; i += (G - nb0) * 512) {
                const f32x4 p0 = __builtin_nontemporal_load((const f32x4*)(a.in[1] + (size_t)i * 8)), p1 = __builtin_nontemporal_load((const f32x4*)(a.in[1] + (size_t)i * 8 + 4));
                u32x4 w4; w4[0] = cvtpk(p0[0], p0[1]); w4[1] = cvtpk(p0[2], p0[3]); w4[2] = cvtpk(p1[0], p1[1]); w4[3] = cvtpk(p1[2], p1[3]);
                *(u32x4*)(PB + (size_t)i * 8) = w4;
            }
        }
        __syncthreads();
        float lam;
        { float s1 = 0.f, s2 = 0.f;
          for (int i = 0; i < 64; ++i) { s1 += a.in[10][i] * a.in[11][i]; s2 += a.in[12][i] * a.in[13][i]; }
          lam = expf(s1) - expf(s2) + 0.2f; }
        unsigned* queue = (unsigned*)(ctl + C_QUEUE);
        int qx = (int)(xb_xcc_id() & 7u), tries = 0;
        auto pop = [&]() -> unsigned {
            while (tries < 8) { const unsigned i = atomicAdd(queue + 16 * qx, 1u); if (i < 128u) return ((unsigned)qx << 7) | i; qx = (qx + 1) & 7; ++tries; }
            return 0xffffffffu; };
        if (tid == 0) lds_st<unsigned>(L + A_QSLOT, pop());
        __syncthreads();
        for (;;) {
            const unsigned u = lds_ld<unsigned>(L + A_QSLOT);
            if (u == 0xffffffffu) break;
            unsigned nxt = 0u;
            if (tid == 0) nxt = pop();
            attn_unit(L, (int)((u >> 7) + 8u * (u & 7u)), 15 - (int)((u >> 3) & 15u), PROJ, PROJ + PS, PROJ + 2 * PS, YA, a.in[8], a.in[9], a.in[15], a.in[14], lam);
            if (tid == 0) lds_st<unsigned>(L + A_QSLOT, nxt);
            __syncthreads();
        }
    }
    SEAM(4);
    if (IN(5)) {
        static_assert(WS_WB == WS_WA + (size_t)DM * 1024 * 2, "Wa_t and Wb_t are contiguous");
        pg8::Gemm g_{(const pg8::bf16_t*)YA, (const pg8::bf16_t*)Wa_t, 2 * TOK, 2 * DM, 1024}; MergeOrder S_; S_.init(G, bx);
        EpiMerge2 E{GAB, GAB + (size_t)TOK * 2048, MERGED};
        pg8::gemm_phase<EpiMerge2, MergeOrder, true, true>(LG, g_, S_, E);
    }
    SEAM(5);
    if (IN(6)) { EpiResid E{OUT, OUT, XB, ctl + C_SS3, 1.0f}; RUN_GEMM(EpiResid, MERGED, Wo_t, DM, DM, E); }
    SEAM(6);
    if (IN(7)) {
        { EpiSwiglu E{ACT, ctl + C_SS3}; RUN_GEMM(EpiSwiglu, XB, Wgu_t, 2 * FF, DM, E); }
        { int kple = 256; asm volatile("" : "+s"(kple)); EpiPle E{PLE, ctl + C_SSP}; RUN_GEMM(EpiPle, PB, Wpp_t, DM, kple, E); }
    }
    SEAM(7);
    if (IN(8)) { EpiResid E{OUT, OUT, XB, ctl + C_SS4, 0.5f}; RUN_GEMM(EpiResid, ACT, Wd_t, DM, FF, E); }
    SEAM(8);
    if (IN(9)) { EpiFinal E{OUT, PLE, ctl + C_SS4, ctl + C_SSP, a.in[28]}; RUN_GEMM(EpiFinal, XB, Wpg_t, DM, DM, E); }
#undef IN
#undef SEAM
#undef RUN_GEMM
}

#ifndef MK_PER_PHASE
#define MK_PER_PHASE 0
#endif
extern "C" void kernel_launch(void* const* d_in, const int* in_sizes, int n_in, void* d_out, int out_size, void* d_ws, size_t ws_size, hipStream_t stream) {
    static int grid = 0;
    if (grid == 0) {
        if (n_in != 29 || out_size != TOK * DM || ws_size < WS_END) { fprintf(stderr, "kernel_launch: unexpected problem: n_in %d out %d ws %zu (need >= %zu)\n", n_in, out_size, ws_size, (size_t)WS_END); grid = -1; return; }
        int dev = 0, cus = 0, per_cu = 0;
        (void)hipGetDevice(&dev); (void)hipDeviceGetAttribute(&cus, hipDeviceAttributeMultiprocessorCount, dev);
        if (hipFuncSetAttribute((const void*)fwd_megakernel, hipFuncAttributeMaxDynamicSharedMemorySize, LDS_BYTES) != hipSuccess) { fprintf(stderr, "kernel_launch: hipFuncSetAttribute failed\n"); grid = -1; return; }
        if (hipOccupancyMaxActiveBlocksPerMultiprocessor(&per_cu, (const void*)fwd_megakernel, 512, LDS_BYTES) != hipSuccess || per_cu < 1) { fprintf(stderr, "kernel_launch: occupancy query says %d\n", per_cu); per_cu = 1; }
        (void)hipGetLastError();
        grid = cus;
        if (grid <= 0) grid = 256;
    }
    if (grid < 0) return;
    if (hipMemsetAsync((char*)d_ws + WS_BAR, 0, 16384, stream) != hipSuccess) { fprintf(stderr, "kernel_launch: memset failed\n"); return; }
    Args a{};
    for (int i = 0; i < 29; ++i) a.in[i] = (const float*)d_in[i];
    a.out = (float*)d_out; a.ws = (unsigned char*)d_ws;
#if MK_PER_PHASE
    for (int p = 0; p < N_PHASES; ++p) { a.ph_lo = p; a.ph_hi = p + 1; hipLaunchKernelGGL(fwd_megakernel, dim3(grid), dim3(512), LDS_BYTES, stream, a); }
#else
    a.ph_lo = 0; a.ph_hi = N_PHASES;
    void* args[] = {&a};
    hipError_t e = hipLaunchCooperativeKernel((const void*)fwd_megakernel, dim3(grid), dim3(512), args, LDS_BYTES, stream);
    if (e != hipSuccess) fprintf(stderr, "kernel_launch: cooperative launch failed: %s (grid %d)\n", hipGetErrorString(e), grid);
#endif
}
```
